# Optimizing an MI355X kernel written in HIP

```python
import math
import jax, jax.numpy as jnp
from jax import lax
import numpy as np

D_MODEL = 4096
BATCH = 1
SEQ = 16384
DEPTH = 2

HEAD_DIM = 128
SWA_Q_HEADS = D_MODEL // (2 * HEAD_DIM)
SWA_KV_HEADS = max(SWA_Q_HEADS // 8, 1)
SWA_GROUP = SWA_Q_HEADS // SWA_KV_HEADS
WINDOW = 128
BLOCK = 128
DIFF_HEADS = D_MODEL // (4 * HEAD_DIM)
DIFF_V_DIM = 2 * HEAD_DIM
MIX_WIDTH = SWA_Q_HEADS * HEAD_DIM + DIFF_HEADS * DIFF_V_DIM
N_BIAS_HEADS = SWA_Q_HEADS + DIFF_HEADS
NUM_BUCKETS = 32
MAX_EXACT = NUM_BUCKETS // 2
MAX_DISTANCE = 128
D_FF = ((8 * D_MODEL // 3 + 255) // 256) * 256
CONV_WIDTH = 3
N_MOD = 6
EPS = 1e-6
NEG_INF = -1e30

QA_COLS = SWA_Q_HEADS * HEAD_DIM
KA_COLS = SWA_KV_HEADS * HEAD_DIM
VA_COLS = SWA_KV_HEADS * HEAD_DIM
QB_COLS = DIFF_HEADS * 2 * HEAD_DIM
KB_COLS = DIFF_HEADS * 2 * HEAD_DIM
VB_COLS = DIFF_HEADS * DIFF_V_DIM
IN_COLS = QA_COLS + KA_COLS + VA_COLS + QB_COLS + KB_COLS + VB_COLS
COL_SPLITS = [QA_COLS, QA_COLS + KA_COLS, QA_COLS + KA_COLS + VA_COLS,
              QA_COLS + KA_COLS + VA_COLS + QB_COLS,
              QA_COLS + KA_COLS + VA_COLS + QB_COLS + KB_COLS]

kernel_name = "hymba_swa_sink_diffattn_convffn_adaln"


def rmsnorm(x, g):
    xf = x.astype(jnp.float32)
    y = xf * lax.rsqrt(jnp.mean(xf * xf, axis=-1, keepdims=True) + EPS)
    return (y * g.astype(jnp.float32)).astype(x.dtype)


def modulate(x, g, shift, scale):
    return rmsnorm(x, g) * (1 + scale[:, None, :]) + shift[:, None, :]


def t5_bucket(n):
    n = jnp.maximum(n, 0)
    nf = jnp.maximum(n, 1).astype(jnp.float32)
    large = MAX_EXACT + (jnp.log(nf / MAX_EXACT) / math.log(MAX_DISTANCE / MAX_EXACT)
                         * (NUM_BUCKETS - MAX_EXACT)).astype(jnp.int32)
    large = jnp.minimum(large, NUM_BUCKETS - 1)
    return jnp.where(n < MAX_EXACT, n, large)


def sliding_window_attention(q, k, v, sinks, rel_bias_a):
    B, S = q.shape[0], q.shape[1]
    nb = S // BLOCK
    q = q.reshape(B, nb, BLOCK, SWA_KV_HEADS, SWA_GROUP, HEAD_DIM)

    def band(t):
        t = t.reshape(B, S, SWA_KV_HEADS, HEAD_DIM)
        t = jnp.pad(t, ((0, 0), (BLOCK, 0), (0, 0), (0, 0)))
        t = t.reshape(B, nb + 1, BLOCK, SWA_KV_HEADS, HEAD_DIM)
        return jnp.concatenate([t[:, :-1], t[:, 1:]], axis=2)

    k_band, v_band = band(k), band(v)
    logits = jnp.einsum('bnqhgd,bnkhd->bnhgqk', q, k_band).astype(jnp.float32) * (HEAD_DIM ** -0.5)
    qa = jnp.arange(BLOCK)
    kb = jnp.arange(2 * BLOCK)
    dist = BLOCK + qa[:, None] - kb[None, :]
    bias = rel_bias_a[t5_bucket(dist)].astype(jnp.float32)
    bias = jnp.transpose(bias, (2, 0, 1)).reshape(SWA_KV_HEADS, SWA_GROUP, BLOCK, 2 * BLOCK)
    kpos = (jnp.arange(nb)[:, None] - 1) * BLOCK + kb[None, :]
    valid = ((dist >= 0) & (dist < WINDOW))[None] & (kpos >= 0)[:, None, :]
    logits = jnp.where(valid[None, :, None, None], logits + bias, NEG_INF)
    sink = jnp.broadcast_to(sinks.astype(jnp.float32).reshape(SWA_KV_HEADS, SWA_GROUP, 1, 1),
                            logits.shape[:-1] + (1,))
    probs = jax.nn.softmax(jnp.concatenate([logits, sink], axis=-1), axis=-1)[..., :-1]
    out = jnp.einsum('bnhgqk,bnkhd->bnqhgd', probs.astype(v_band.dtype), v_band)
    return out.reshape(B, S, SWA_Q_HEADS * HEAD_DIM)


def differential_attention(q, k, v, lq1, lk1, lq2, lk2, subln_g, rel_bias_b, lam_init):
    B, S = q.shape[0], q.shape[1]
    nb = S // BLOCK
    q = q.reshape(B, nb, BLOCK, DIFF_HEADS, 2, HEAD_DIM).transpose(1, 0, 2, 3, 4, 5)
    k = k.reshape(B, S, DIFF_HEADS, 2, HEAD_DIM)
    v = v.reshape(B, S, DIFF_HEADS, DIFF_V_DIM)
    lam = (jnp.exp(jnp.sum(lq1.astype(jnp.float32) * lk1.astype(jnp.float32)))
           - jnp.exp(jnp.sum(lq2.astype(jnp.float32) * lk2.astype(jnp.float32))) + lam_init)
    kpos = jnp.arange(S)

    def one_block(args):
        qb, i = args
        logits = jnp.einsum('bqhcd,bkhcd->bhcqk', qb, k).astype(jnp.float32) * (HEAD_DIM ** -0.5)
        n = (i * BLOCK + jnp.arange(BLOCK))[:, None] - kpos[None, :]
        bias = jnp.transpose(rel_bias_b[t5_bucket(n)], (2, 0, 1)).astype(jnp.float32)
        logits = jnp.where((n >= 0)[None, None, None], logits + bias[None, :, None], NEG_INF)
        p = jax.nn.softmax(logits, axis=-1)
        a = p[:, :, 0] - lam * p[:, :, 1]
        return jnp.einsum('bhqk,bkhe->bqhe', a.astype(v.dtype), v)

    out = lax.map(one_block, (q, jnp.arange(nb)))
    out = out.transpose(1, 0, 2, 3, 4).reshape(B, S, DIFF_HEADS, DIFF_V_DIM)
    out = rmsnorm(out, subln_g) * (1 - lam_init)
    return out.reshape(B, S, DIFF_HEADS * DIFF_V_DIM)


def conv_ffn(h, w_up, conv_w, conv_b, w_down):
    S = h.shape[1]
    u = h @ w_up
    gate, up = jnp.split(u, [D_FF], axis=-1)
    gp = jnp.pad(gate, ((0, 0), (CONV_WIDTH - 1, 0), (0, 0)))
    conv = conv_b
    for j in range(CONV_WIDTH):
        conv = conv + gp[:, j:j + S] * conv_w[j]
    return (jax.nn.silu(conv) * up) @ w_down


def setup_inputs(seed: int = 0) -> dict:
    key = jax.random.key(seed)
    ks = jax.random.split(key, 20)
    f = jnp.float32
    nrm = lambda k, shape, s: jax.random.normal(k, shape, f) * s
    return {
        "x": nrm(ks[0], (BATCH, SEQ, D_MODEL), 1.0),
        "c": nrm(ks[1], (BATCH, D_MODEL), 1.0),
        "ada_w": nrm(ks[2], (DEPTH, D_MODEL, N_MOD * D_MODEL), D_MODEL ** -0.5),
        "ada_b": nrm(ks[3], (DEPTH, N_MOD * D_MODEL), 0.02),
        "attn_norm_g": 1.0 + nrm(ks[4], (DEPTH, D_MODEL), 0.02),
        "mlp_norm_g": 1.0 + nrm(ks[5], (DEPTH, D_MODEL), 0.02),
        "w_in": nrm(ks[6], (DEPTH, D_MODEL, IN_COLS), D_MODEL ** -0.5),
        "swa_sinks": nrm(ks[7], (DEPTH, SWA_Q_HEADS), 1.0),
        "diff_lq1": nrm(ks[8], (DEPTH, HEAD_DIM), 0.1),
        "diff_lk1": nrm(ks[9], (DEPTH, HEAD_DIM), 0.1),
        "diff_lq2": nrm(ks[10], (DEPTH, HEAD_DIM), 0.1),
        "diff_lk2": nrm(ks[11], (DEPTH, HEAD_DIM), 0.1),
        "diff_subln_g": 1.0 + nrm(ks[12], (DEPTH, DIFF_V_DIM), 0.02),
        "w_out": nrm(ks[13], (DEPTH, MIX_WIDTH, D_MODEL), MIX_WIDTH ** -0.5),
        "rel_bias": nrm(ks[14], (NUM_BUCKETS, N_BIAS_HEADS), 0.5),
        "w_up": nrm(ks[15], (DEPTH, D_MODEL, 2 * D_FF), D_MODEL ** -0.5),
        "conv_w": nrm(ks[16], (DEPTH, CONV_WIDTH, D_FF), CONV_WIDTH ** -0.5),
        "conv_b": nrm(ks[17], (DEPTH, D_FF), 0.02),
        "w_down": nrm(ks[18], (DEPTH, D_FF, D_MODEL), D_FF ** -0.5),
        "final_g": 1.0 + nrm(ks[19], (D_MODEL,), 0.02),
    }


def reference(x, c, ada_w, ada_b, attn_norm_g, mlp_norm_g, w_in, swa_sinks, diff_lq1, diff_lk1,
              diff_lq2, diff_lk2, diff_subln_g, w_out, rel_bias, w_up, conv_w, conv_b, w_down, final_g):
    rel_a = rel_bias[:, :SWA_Q_HEADS]
    rel_b = rel_bias[:, SWA_Q_HEADS:]
    cs = jax.nn.silu(c)
    for l in range(DEPTH):
        mod = cs @ ada_w[l] + ada_b[l]
        sh_a, sc_a, g_a, sh_m, sc_m, g_m = jnp.split(mod, N_MOD, axis=-1)
        h = modulate(x, attn_norm_g[l], sh_a, sc_a)
        proj = h @ w_in[l]
        qa, ka, va, qb, kb, vb = jnp.split(proj, COL_SPLITS, axis=-1)
        ya = sliding_window_attention(qa, ka, va, swa_sinks[l], rel_a)
        lam_init = 0.8 - 0.6 * math.exp(-0.3 * l)
        yb = differential_attention(qb, kb, vb, diff_lq1[l], diff_lk1[l], diff_lq2[l], diff_lk2[l],
                                    diff_subln_g[l], rel_b, lam_init)
        mix = jnp.concatenate([ya, yb], axis=-1)
        x = x + g_a[:, None, :] * (mix @ w_out[l])
        h = modulate(x, mlp_norm_g[l], sh_m, sc_m)
        x = x + g_m[:, None, :] * conv_ffn(h, w_up[l], conv_w[l], conv_b[l], w_down[l])
    return rmsnorm(x, final_g)
```

```cpp
#include <hip/hip_runtime.h>
#include <cstdio>
#include <cstdint>

#ifndef MK_PER_PHASE
#define MK_PER_PHASE 0
#endif

#ifndef MK_DUP
#define MK_DUP 0
#endif
#ifndef MK_PROBE
#define MK_PROBE 0
#endif
#ifndef MK_PROBE_LAYER
#define MK_PROBE_LAYER 0
#endif
#define LAS __attribute__((address_space(3)))
template <int M> __device__ __forceinline__ float swz_xor(float v) { return __builtin_bit_cast(float, __builtin_amdgcn_ds_swizzle(__builtin_bit_cast(int, v), (M << 10) | 0x1f)); }
__device__ __forceinline__ void swap32(float& a, float& b) { asm volatile("s_nop 1\n\tv_permlane32_swap_b32 %0, %1" : "+v"(a), "+v"(b)); }
__device__ __forceinline__ float xhalf_sum(float x) { float a = x, b = x; swap32(a, b); return a + b; }
__device__ __forceinline__ float xhalf_max(float x) { float a = x, b = x; swap32(a, b); return fmaxf(a, b); }
__device__ __forceinline__ float wave_sum(float v) {
    v += swz_xor<1>(v); v += swz_xor<2>(v); v += swz_xor<4>(v); v += swz_xor<8>(v); v += swz_xor<16>(v); return xhalf_sum(v);
}
__device__ __forceinline__ int fresh_lane() { unsigned z = 0u; asm volatile("" : "+v"(z)); return (int)__builtin_amdgcn_mbcnt_hi(~0u, __builtin_amdgcn_mbcnt_lo(~0u, z)); }
namespace pg8 {
#define PG8_LAS __attribute__((address_space(3)))
typedef unsigned short bf16_t;
typedef short bf16x8 __attribute__((ext_vector_type(8)));
typedef float f32x4 __attribute__((ext_vector_type(4)));
typedef unsigned u32x4 __attribute__((ext_vector_type(4)));
constexpr int BM = 256, BK = 64, HALF = 128, HTB = HALF * BK * 2  , STAGE_BYTES = 8 * HTB, NXCD = 8, WGM = 8;

__host__ __device__ __forceinline__ int lds_byte(int r, int c) { const int st = (r >> 4) * 2 + (c >> 5), rr = r & 15, cc = c & 31, ob = rr * 64 + cc * 2; return st * 1024 + (ob ^ (((ob >> 9) & 1) << 5)); }
__host__ __device__ __forceinline__ void stage_rc(int b, int& R, int& C) { const int st = b / 1024, sb = b % 1024, swz = sb ^ (((sb >> 9) & 1) << 5); R = (st >> 1) * 16 + swz / 64; C = (st & 1) * 32 + (swz % 64) / 2; }
__host__ __device__ __forceinline__ int perm32(int rho) { const int n = rho >> 4, i = rho & 15; return 8 * (i >> 2) + 4 * n + (i & 3); }

struct Unit { int pm, pn; };
struct Gemm { const bf16_t* A; const bf16_t* Bt; int M, N, K; };

struct StaticOrder {
    int nM, nN, nwg, G, c;
    __host__ __device__ void init(int M, int N, int G_, int c_) { nM = M / BM; nN = N / BM; nwg = nM * nN; G = G_; c = c_; }
    __host__ __device__ bool next(int i, Unit& u) const {
        const long L = (long)i * G + c; if (L >= nwg) return false;
        int wgid = (int)L; { const int q = nwg / NXCD, r = nwg % NXCD, xcd = wgid % NXCD, off = wgid / NXCD; wgid = (xcd < r ? xcd * (q + 1) : r * (q + 1) + (xcd - r) * q) + off; }
        const int nig = WGM * nN, gid = wgid / nig, fm = gid * WGM, gsz = (nM - fm) < WGM ? (nM - fm) : WGM;
        u.pm = fm + ((wgid % nig) % gsz); u.pn = (wgid % nig) / gsz; return true;
    }
    __device__ __forceinline__ void a_ready(const Unit&) const {}
    __device__ __forceinline__ void done(const Unit&) const {}
};

__device__ __forceinline__ unsigned cvt_pk_bf16(float lo, float hi) { unsigned r; asm volatile("v_cvt_pk_bf16_f32 %0, %1, %2" : "=v"(r) : "v"(lo), "v"(hi)); return r; }

struct EpiBf16 {
    static constexpr bool PERM = true, AFTER_DRAIN = false;
    bf16_t* O; int ldc;
    __device__ __forceinline__ void operator()(const f32x4 (&acc)[2][2][4][2], const Unit& u, int wr, int wc, int fr, int fq) const {
        const int row0 = u.pm * BM + wr * 64 + fr; const int col0 = u.pn * BM + wc * 32 + 8 * fq;
#pragma unroll
        for (int ai = 0; ai < 2; ++ai)
#pragma unroll
            for (int m = 0; m < 4; ++m) { bf16_t* rowp = O + (size_t)(row0 + ai * HALF + m * 16) * ldc + col0;
#pragma unroll
                for (int bj = 0; bj < 2; ++bj) { const f32x4 v0 = acc[ai][bj][m][0], v1 = acc[ai][bj][m][1];
                    u32x4 w; w.x = cvt_pk_bf16(v0[0], v0[1]); w.y = cvt_pk_bf16(v0[2], v0[3]); w.z = cvt_pk_bf16(v1[0], v1[1]); w.w = cvt_pk_bf16(v1[2], v1[3]);
                    *(u32x4*)(rowp + bj * HALF) = w; } }
    }
    __device__ __forceinline__ void fused(f32x4 (&)[2][2][4][2], const Unit&, int, int, int, int, PG8_LAS unsigned char*, int, int) const {}
};
struct EpiResGate {
    static constexpr bool PERM = false, AFTER_DRAIN = false;
    const float* base; float* out; int ldc; const float* gate;
    __device__ __forceinline__ void operator()(const f32x4 (&acc)[2][2][4][2], const Unit& u, int wr, int wc, int fr, int fq) const {
        const int row0 = u.pm * BM + wr * 64 + fr, col0 = u.pn * BM + wc * 32 + 4 * fq;
        f32x4 gv[2][2];
#pragma unroll
        for (int bj = 0; bj < 2; ++bj)
#pragma unroll
            for (int n = 0; n < 2; ++n) gv[bj][n] = *(const f32x4*)(gate + col0 + bj * HALF + n * 16);
#pragma unroll
        for (int ai = 0; ai < 2; ++ai)
#pragma unroll
            for (int mp = 0; mp < 4; mp += 2) {
                f32x4 bs[2][2][2];
#pragma unroll
                for (int mm = 0; mm < 2; ++mm) { const size_t off = (size_t)(row0 + ai * HALF + (mp + mm) * 16) * ldc + col0;
#pragma unroll
                    for (int bj = 0; bj < 2; ++bj)
#pragma unroll
                        for (int n = 0; n < 2; ++n) bs[mm][bj][n] = *(const f32x4*)(base + off + bj * HALF + n * 16); }
                asm volatile("" ::: "memory");
#pragma unroll
                for (int mm = 0; mm < 2; ++mm) { const size_t off = (size_t)(row0 + ai * HALF + (mp + mm) * 16) * ldc + col0;
#pragma unroll
                    for (int bj = 0; bj < 2; ++bj)
#pragma unroll
                        for (int n = 0; n < 2; ++n) *(f32x4*)(out + off + bj * HALF + n * 16) = bs[mm][bj][n] + gv[bj][n] * acc[ai][bj][mp + mm][n]; }
                asm volatile("" ::: "memory"); }
    }
    __device__ __forceinline__ void fused(f32x4 (&)[2][2][4][2], const Unit&, int, int, int, int, PG8_LAS unsigned char*, int, int) const {}
};


__device__ __forceinline__ float dpp_shr1(float old, float src) { return __builtin_bit_cast(float, __builtin_amdgcn_update_dpp(__builtin_bit_cast(int, old), __builtin_bit_cast(int, src), 0x111, 0xf, 0xf, false)); }
__device__ __forceinline__ float dpp_shr2(float old, float src) { return __builtin_bit_cast(float, __builtin_amdgcn_update_dpp(__builtin_bit_cast(int, old), __builtin_bit_cast(int, src), 0x112, 0xf, 0xf, false)); }
__device__ __forceinline__ float dpp_ror1(float src) { return __builtin_bit_cast(float, __builtin_amdgcn_update_dpp(0, __builtin_bit_cast(int, src), 0x121, 0xf, 0xf, false)); }
__device__ __forceinline__ float dpp_ror2(float src) { return __builtin_bit_cast(float, __builtin_amdgcn_update_dpp(0, __builtin_bit_cast(int, src), 0x122, 0xf, 0xf, false)); }
struct EpiConvGate {
    static constexpr bool PERM = true, AFTER_DRAIN = false;
    bf16_t* ACT; int dff; const float* cw; const float* cb; float* halo; float* fixc; float* fixu; PG8_LAS f32x4* xch;
    __device__ __forceinline__ void operator()(const f32x4 (&acc)[2][2][4][2], const Unit& u, int wr, int wc, int fr, int fq) const {
        const int jcol = wc * 32 + 8 * fq, f0 = u.pn * 128 + jcol;
        f32x4 w0[2], w1[2], w2[2], bb[2];
#pragma unroll
        for (int n = 0; n < 2; ++n) { w0[n] = *(const f32x4*)(cw + f0 + 4 * n); w1[n] = *(const f32x4*)(cw + dff + f0 + 4 * n); w2[n] = *(const f32x4*)(cw + 2 * dff + f0 + 4 * n); bb[n] = *(const f32x4*)(cb + f0 + 4 * n); }
#pragma unroll
        for (int ai = 0; ai < 2; ++ai) if (fr >= 14) {
#pragma unroll
            for (int n = 0; n < 2; ++n) xch[((((ai * 2 + wr) * 4 + wc) * 4 + fq) * 2 + (fr - 14)) * 2 + n] = acc[ai][0][3][n]; }
        if (wr == 1 && fr >= 14) {
#pragma unroll
            for (int n = 0; n < 2; ++n) *(f32x4*)(halo + ((size_t)u.pm * 2 + (fr - 14)) * dff + f0 + 4 * n) = acc[1][0][3][n]; }
        asm volatile("s_waitcnt lgkmcnt(0)" ::: "memory"); __builtin_amdgcn_s_barrier(); asm volatile("" ::: "memory");
#pragma unroll
        for (int ai = 0; ai < 2; ++ai) {
            f32x4 p62[2], p63[2];
            const bool has_prev = (ai == 1) || (wr == 1);
            const int pai = (wr == 1) ? ai : 0, pwr = (wr == 1) ? 0 : 1;
#pragma unroll
            for (int n = 0; n < 2; ++n) { if (has_prev) { p62[n] = xch[((((pai * 2 + pwr) * 4 + wc) * 4 + fq) * 2 + 0) * 2 + n]; p63[n] = xch[((((pai * 2 + pwr) * 4 + wc) * 4 + fq) * 2 + 1) * 2 + n]; }
                                          else { p62[n] = (f32x4){0.f, 0.f, 0.f, 0.f}; p63[n] = p62[n]; } }
#pragma unroll
            for (int m = 0; m < 4; ++m) {
                const int row = u.pm * BM + ai * HALF + wr * 64 + m * 16 + fr;
                u32x4 ow; float cvv[8], upv[8];
#pragma unroll
                for (int n = 0; n < 2; ++n)
#pragma unroll
                    for (int e = 0; e < 4; ++e) {
                        const float g0 = acc[ai][0][m][n][e];
                        float o1, o2;
                        if (m == 0) { o1 = p63[n][e]; o2 = (fr == 0) ? p62[n][e] : p63[n][e]; }
                        else { o1 = dpp_ror1(acc[ai][0][m - 1][n][e]); o2 = dpp_ror2(acc[ai][0][m - 1][n][e]); }
                        const float g1 = dpp_shr1(o1, g0), g2 = dpp_shr2(o2, g0);
                        const float cv = bb[n][e] + w0[n][e] * g2 + w1[n][e] * g1 + w2[n][e] * g0;
                        cvv[4 * n + e] = cv; upv[4 * n + e] = acc[ai][1][m][n][e];
                    }
                float ov[8];
#pragma unroll
                for (int k = 0; k < 8; ++k) ov[k] = cvv[k] * __builtin_amdgcn_rcpf(1.0f + __builtin_amdgcn_exp2f(-1.4426950408889634f * cvv[k])) * upv[k];
                ow.x = cvt_pk_bf16(ov[0], ov[1]); ow.y = cvt_pk_bf16(ov[2], ov[3]); ow.z = cvt_pk_bf16(ov[4], ov[5]); ow.w = cvt_pk_bf16(ov[6], ov[7]);
                *(u32x4*)(ACT + (size_t)row * dff + f0) = ow;
                if (ai == 0 && m == 0 && wr == 0 && fr < 2) {
#pragma unroll
                    for (int n = 0; n < 2; ++n) { *(f32x4*)(fixc + ((size_t)u.pm * 2 + fr) * dff + f0 + 4 * n) = (f32x4){cvv[4 * n], cvv[4 * n + 1], cvv[4 * n + 2], cvv[4 * n + 3]};
                                                  *(f32x4*)(fixu + ((size_t)u.pm * 2 + fr) * dff + f0 + 4 * n) = (f32x4){upv[4 * n], upv[4 * n + 1], upv[4 * n + 2], upv[4 * n + 3]}; } }
            }
        }
    }
    __device__ __forceinline__ void fused(f32x4 (&)[2][2][4][2], const Unit&, int, int, int, int, PG8_LAS unsigned char*, int, int) const {}
};
template <class Epi, class Sched, bool ALIGN_EPI = false, bool SP2 = false>
__device__ __forceinline__ void gemm_phase(PG8_LAS unsigned char* lds, const Gemm g, const Sched& S, const Epi& E, const int wave_in) {
    int tid_ = wave_in * 64 + fresh_lane();
    const int tid = tid_, wid = __builtin_amdgcn_readfirstlane(tid >> 6), lane = tid & 63, wr = wid >> 2, wc = wid & 3, fr = lane & 15, fq = lane >> 4;
    const int K = g.K, nt = K / BK;
    unsigned voffA[2], voffB[2];
#pragma unroll
    for (int i = 0; i < 2; ++i) { int R, C; stage_rc(tid * 16 + i * 8192, R, C); const int Rb = Epi::PERM ? ((R & ~31) + perm32(R & 31)) : R;
        voffA[i] = (unsigned)(R * K + C) * 2u; voffB[i] = (unsigned)(Rb * K + C) * 2u; }
    const size_t kstep = (size_t)(BK * 2);
    const size_t hstep = (size_t)HALF * K * 2;
    const size_t tstep = 2 * hstep;
    const unsigned ldsw = (unsigned)wid * 1024u;
    const int aoff = lds_byte(wr * 64 + fr, fq * 8), boff = lds_byte(wc * 32 + fr, fq * 8);
#define PG8_SA(b, h) (((b) * 2 + (h)) * HTB)
#define PG8_SB(b, h) ((4 + (b) * 2 + (h)) * HTB)
#define PG8_STAGE(bufoff, gbase, voff) do { _Pragma("unroll") for (int _i = 0; _i < 2; ++_i) \
        __builtin_amdgcn_global_load_lds((const unsigned*)((const char*)(gbase) + (voff)[_i]), (PG8_LAS unsigned*)(lds + (bufoff) + ldsw + _i * 8192), 16, 0, 0); } while (0)
#define PG8_LDA(dst, b, h) do { _Pragma("unroll") for (int m = 0; m < 4; ++m) _Pragma("unroll") for (int k = 0; k < 2; ++k) dst[m][k] = *(const PG8_LAS bf16x8*)(lds + PG8_SA(b, h) + aoff + m * 2048 + k * 1024); } while (0)
#define PG8_LDB(dst, b, h) do { _Pragma("unroll") for (int n = 0; n < 2; ++n) _Pragma("unroll") for (int k = 0; k < 2; ++k) dst[n][k] = *(const PG8_LAS bf16x8*)(lds + PG8_SB(b, h) + boff + n * 2048 + k * 1024); } while (0)
#define PG8_MMA(ai, bj, At, Bt) do { __builtin_amdgcn_s_setprio(1); _Pragma("unroll") for (int m = 0; m < 4; ++m) _Pragma("unroll") for (int n = 0; n < 2; ++n) _Pragma("unroll") for (int k = 0; k < 2; ++k) \
        acc[ai][bj][m][n] = __builtin_amdgcn_mfma_f32_16x16x32_bf16(Bt[n][k], At[m][k], acc[ai][bj][m][n], 0, 0, 0); __builtin_amdgcn_s_setprio(0); } while (0)
#define PG8_WAIT_V(n) asm volatile("s_waitcnt vmcnt(" #n ")" ::: "memory")
#define PG8_WAIT_L(n) asm volatile("s_waitcnt lgkmcnt(" #n ")" ::: "memory")
#define PG8_BAR __builtin_amdgcn_s_barrier()
#define PG8_SCHED __builtin_amdgcn_sched_barrier(0)
    Unit cur, nxt; int ui = 0;
    if (!S.next(0, cur)) return;
    f32x4 acc[2][2][4][2];
#pragma unroll
    for (int a = 0; a < 2; ++a)
#pragma unroll
        for (int b = 0; b < 2; ++b)
#pragma unroll
            for (int m = 0; m < 4; ++m)
#pragma unroll
                for (int n = 0; n < 2; ++n) acc[a][b][m][n] = (f32x4){0.f, 0.f, 0.f, 0.f};
    bf16x8 At[4][2], B0[2][2], B1[2][2];
    const char* cA = (const char*)g.A + (size_t)cur.pm * tstep; const char* cB = (const char*)g.Bt + (size_t)cur.pn * tstep;
    S.a_ready(cur);
    if constexpr (SP2) {
        PG8_STAGE(PG8_SB(0, 0), cB, voffB); PG8_STAGE(PG8_SB(0, 1), cB + hstep, voffB); PG8_STAGE(PG8_SA(0, 0), cA, voffA); PG8_STAGE(PG8_SA(0, 1), cA + hstep, voffA);
        if (wr == 1) PG8_BAR;
        PG8_WAIT_V(2); PG8_BAR;
        PG8_STAGE(PG8_SB(1, 0), cB + kstep, voffB); PG8_STAGE(PG8_SA(1, 0), cA + kstep, voffA); PG8_STAGE(PG8_SB(1, 1), cB + hstep + kstep, voffB);
        PG8_WAIT_V(6); PG8_BAR;
    } else {
        PG8_STAGE(PG8_SB(0, 0), cB, voffB); PG8_STAGE(PG8_SA(0, 0), cA, voffA); PG8_STAGE(PG8_SB(0, 1), cB + hstep, voffB); PG8_STAGE(PG8_SA(0, 1), cA + hstep, voffA);
        if (wr == 1) PG8_BAR;
        PG8_WAIT_V(4); PG8_BAR;
        PG8_STAGE(PG8_SB(1, 0), cB + kstep, voffB); PG8_STAGE(PG8_SA(1, 0), cA + kstep, voffA); PG8_STAGE(PG8_SB(1, 1), cB + hstep + kstep, voffB);
        PG8_WAIT_V(6); PG8_BAR;
    }
    for (;;) {
        const bool has_next = S.next(ui + 1, nxt);
        const char* nA = has_next ? (const char*)g.A + (size_t)nxt.pm * tstep : cA; const char* nB = has_next ? (const char*)g.Bt + (size_t)nxt.pn * tstep : cB;
        for (int t = 0; t < nt; t += 2) {
            const bool last = (t == nt - 2);
            const char* a1 = cA + (size_t)(t + 1) * kstep;
            const char* a2 = last ? nA : cA + (size_t)(t + 2) * kstep; const char* b2 = last ? nB : cB + (size_t)(t + 2) * kstep;
            const char* a3 = a2 + kstep; const char* b3 = b2 + kstep;
            if (last && has_next) S.a_ready(nxt);
            if constexpr (SP2) {
            PG8_LDB(B0, 0, 0); PG8_LDB(B1, 0, 1); PG8_SCHED; PG8_LDA(At, 0, 0); PG8_STAGE(PG8_SA(1, 1), a1 + hstep, voffA);
            PG8_WAIT_V(8); PG8_WAIT_L(0); PG8_BAR; PG8_MMA(0, 0, At, B0); PG8_MMA(0, 1, At, B1); PG8_BAR; PG8_SCHED;
            PG8_LDA(At, 0, 1); PG8_STAGE(PG8_SB(0, 0), b2, voffB); PG8_STAGE(PG8_SB(0, 1), b2 + hstep, voffB); PG8_STAGE(PG8_SA(0, 0), a2, voffA);
            PG8_WAIT_V(8); PG8_WAIT_L(0); PG8_BAR; PG8_MMA(1, 0, At, B0); PG8_MMA(1, 1, At, B1); PG8_BAR; PG8_SCHED;
            PG8_LDB(B0, 1, 0); PG8_LDB(B1, 1, 1); PG8_SCHED; PG8_LDA(At, 1, 0); PG8_STAGE(PG8_SA(0, 1), a2 + hstep, voffA);
            PG8_WAIT_V(8); PG8_WAIT_L(0); PG8_BAR; PG8_MMA(0, 0, At, B0); PG8_MMA(0, 1, At, B1); PG8_BAR; PG8_SCHED;
            PG8_LDA(At, 1, 1); PG8_STAGE(PG8_SB(1, 0), b3, voffB); PG8_STAGE(PG8_SB(1, 1), b3 + hstep, voffB); PG8_STAGE(PG8_SA(1, 0), a3, voffA);
            PG8_WAIT_V(8); PG8_WAIT_L(0); PG8_BAR; PG8_MMA(1, 0, At, B0); PG8_MMA(1, 1, At, B1); PG8_BAR; PG8_SCHED;
            } else {
            PG8_LDB(B0, 0, 0); PG8_SCHED; PG8_LDA(At, 0, 0); PG8_STAGE(PG8_SA(1, 1), a1 + hstep, voffA);
            PG8_WAIT_L(8); PG8_BAR; PG8_WAIT_L(0); PG8_MMA(0, 0, At, B0); PG8_BAR; PG8_SCHED;
            PG8_LDB(B1, 0, 1); PG8_STAGE(PG8_SB(0, 0), b2, voffB);
            PG8_BAR; PG8_WAIT_L(0); PG8_MMA(0, 1, At, B1); PG8_BAR;
            PG8_LDA(At, 0, 1); PG8_STAGE(PG8_SA(0, 0), a2, voffA);
            PG8_BAR; PG8_WAIT_L(0); PG8_MMA(1, 0, At, B0); PG8_BAR; PG8_SCHED;
            PG8_STAGE(PG8_SB(0, 1), b2 + hstep, voffB);
            PG8_WAIT_V(6); PG8_BAR; PG8_MMA(1, 1, At, B1); PG8_BAR;
            PG8_LDB(B0, 1, 0); PG8_SCHED; PG8_LDA(At, 1, 0); PG8_STAGE(PG8_SA(0, 1), a2 + hstep, voffA);
            PG8_WAIT_L(8); PG8_BAR; PG8_WAIT_L(0); PG8_MMA(0, 0, At, B0); PG8_BAR; PG8_SCHED;
            PG8_LDB(B1, 1, 1); PG8_STAGE(PG8_SB(1, 0), b3, voffB);
            PG8_BAR; PG8_WAIT_L(0); PG8_MMA(0, 1, At, B1); PG8_BAR;
            PG8_LDA(At, 1, 1); PG8_STAGE(PG8_SA(1, 0), a3, voffA);
            PG8_BAR; PG8_WAIT_L(0); PG8_MMA(1, 0, At, B0); PG8_BAR; PG8_SCHED;
            PG8_STAGE(PG8_SB(1, 1), b3 + hstep, voffB);
            PG8_WAIT_V(6); PG8_BAR; PG8_MMA(1, 1, At, B1); PG8_BAR;
            }
        }
        if constexpr (ALIGN_EPI) { if (wr == 0) PG8_BAR; }
        if constexpr (!Epi::AFTER_DRAIN) { E(acc, cur, wr, wc, fr, fq); S.done(cur); }
        if (!has_next) break;
#pragma unroll
        for (int a = 0; a < 2; ++a)
#pragma unroll
            for (int b = 0; b < 2; ++b)
#pragma unroll
                for (int m = 0; m < 4; ++m)
#pragma unroll
                    for (int n = 0; n < 2; ++n) acc[a][b][m][n] = (f32x4){0.f, 0.f, 0.f, 0.f};
        cur = nxt; cA = nA; cB = nB; ++ui;
        if constexpr (ALIGN_EPI) { if (wr == 1) PG8_BAR; }
    }
    PG8_WAIT_V(0);
    if constexpr (!ALIGN_EPI) { if (wr == 0) PG8_BAR; }
    PG8_BAR;
    if constexpr (Epi::AFTER_DRAIN) { E.fused(acc, cur, wr, wc, fr, fq, lds, wid, lane); S.done(cur); }
#undef PG8_SA
#undef PG8_SB
#undef PG8_STAGE
#undef PG8_LDA
#undef PG8_LDB
#undef PG8_MMA
#undef PG8_WAIT_V
#undef PG8_WAIT_L
#undef PG8_BAR
#undef PG8_SCHED
}
}
#define XB_TMO      128
#define XB_XCNT(j)  (256  + 64 * (j))
#define XB_XSUB(j)  (1280 + 64 * (j))
#define XB_XGEN(j)  (2304 + 64 * (j))
#define XB_TOP      3328
#define XB_TOPGEN   3392
#define XCD_BAR_WORDS 3456
#define XB_SPIN_CAP (1u << 18)

__device__ __forceinline__ unsigned xb_ld(unsigned* p)              { return __hip_atomic_load(p, __ATOMIC_RELAXED, __HIP_MEMORY_SCOPE_AGENT); }
__device__ __forceinline__ unsigned xb_add(unsigned* p, unsigned v) { return __hip_atomic_fetch_add(p, v, __ATOMIC_RELAXED, __HIP_MEMORY_SCOPE_AGENT); }
__device__ __forceinline__ unsigned xb_xcc_id() { return (unsigned)__builtin_amdgcn_s_getreg((3 << 11) | 20) & 0xFu; }
#define XB_SPIN(cond, bar) do { unsigned _sp = 0; while (cond) { __builtin_amdgcn_s_sleep(1); \
    if ((++_sp & 255u) == 0u) { if (xb_ld(&(bar)[XB_TMO])) break; if (_sp > XB_SPIN_CAP) { atomicAdd(&(bar)[XB_TMO], 1u); break; } } } } while (0)

struct XcdBarrier {
    unsigned* bar; unsigned x;
    volatile LAS unsigned* st;
    bool t0;
};

__device__ __forceinline__ XcdBarrier xcd_barrier_post(unsigned* bar, volatile LAS unsigned* st) {
    XcdBarrier b; b.bar = bar; b.x = xb_xcc_id(); b.st = st; b.t0 = (threadIdx.x == 0);
    if (b.t0) (void)xb_add(&bar[XB_XCNT(b.x)], 1u);
    return b;
}
__device__ __forceinline__ void xcd_barrier_complete(unsigned* bar, unsigned x, unsigned& nloc, unsigned& nx) {
    const unsigned G = gridDim.x * gridDim.y * gridDim.z;
    unsigned sum, cnt, mine, sp = 0u;
    for (;;) {
        sum = 0u; cnt = 0u; mine = 0u;
#pragma unroll
        for (unsigned j = 0; j < 16; ++j) { const unsigned c = xb_ld(&bar[XB_XCNT(j)]); sum += c; cnt += (c > 0u) ? 1u : 0u; mine = (j == x) ? c : mine; }
        if (sum == G) break;
        __builtin_amdgcn_s_sleep(1);
        if ((++sp & 255u) == 0u) { if (xb_ld(&bar[XB_TMO])) break; if (sp > XB_SPIN_CAP) { atomicAdd(&bar[XB_TMO], 1u); break; } }
    }
    nloc = mine > 0u ? mine : 1u; nx = cnt > 0u ? cnt : 1u;
}

__device__ __forceinline__ void xcd_barrier(const XcdBarrier& b) {
    asm volatile("s_waitcnt vmcnt(0)" ::: "memory");
    __syncthreads();
    if (b.t0) {
        unsigned* bar = b.bar;
        __builtin_amdgcn_s_waitcnt(0);
        unsigned nloc = b.st[0], nx = b.st[1];
        if (nloc == 0u) { xcd_barrier_complete(bar, b.x, nloc, nx); b.st[0] = nloc; b.st[1] = nx; }
        const unsigned old = xb_add(&bar[XB_XSUB(b.x)], 1u);
        const unsigned gen = old / nloc;
        if (old + 1u == (gen + 1u) * nloc) {
            __builtin_amdgcn_fence(__ATOMIC_RELEASE, "agent");
            asm volatile("s_waitcnt vmcnt(0)" ::: "memory");
            const unsigned og = xb_add(&bar[XB_TOP], 1u);
            const unsigned tg = og / nx;
            if (og + 1u == (tg + 1u) * nx) xb_add(&bar[XB_TOPGEN], 1u);
            else XB_SPIN(xb_ld(&bar[XB_TOPGEN]) == tg, bar);
            __builtin_amdgcn_fence(__ATOMIC_ACQUIRE, "agent");
            xb_add(&bar[XB_XGEN(b.x)], 1u);
            asm volatile("s_waitcnt vmcnt(0)" ::: "memory");
        } else {
            XB_SPIN(xb_ld(&bar[XB_XGEN(b.x)]) == gen, bar);
            __builtin_amdgcn_fence(__ATOMIC_ACQUIRE, "agent");
            asm volatile("s_waitcnt vmcnt(0)" ::: "memory");
        }
    }
    __syncthreads();
}

namespace att {
typedef unsigned short bf16_t;
typedef short bf16x8 __attribute__((ext_vector_type(8)));
typedef short s16x4 __attribute__((ext_vector_type(4)));
typedef float f32x16 __attribute__((ext_vector_type(16)));
typedef float f32x4 __attribute__((ext_vector_type(4)));
typedef unsigned u32x4 __attribute__((ext_vector_type(4)));
#define ALAS __attribute__((address_space(3)))

constexpr int KT = 64, PITCH = 8704, PITCHB = PITCH * 2, QBLK = 256, MIXP = 4096, T1P = 2048;
constexpr int K_BYTES = KT * 256;
constexpr int V_BYTES = KT * 512;
constexpr int NRING = 3;
constexpr int OFF_K = 0, OFF_V = NRING * K_BYTES, OFF_TB = OFF_V + NRING * V_BYTES, OFF_WS = OFF_TB + 512, ATT_LDS = OFF_WS + 8 * 256;
constexpr float LOG2E = 1.4426950408889634f;
constexpr float C2 = 0.12751743082459868f;
constexpr float THR = 8.f;

__device__ __forceinline__ int crow(int r, int hi) { return (r & 3) + 8 * (r >> 2) + 4 * hi; }
__device__ __forceinline__ unsigned cvtpk(float lo, float hi) { unsigned r; asm volatile("v_cvt_pk_bf16_f32 %0, %1, %2" : "=v"(r) : "v"(lo), "v"(hi)); return r; }
__device__ __forceinline__ float half_max(float x) { return xhalf_max(x); }
__device__ __forceinline__ float half_sum(float x) { return xhalf_sum(x); }
__device__ __forceinline__ int t5_bucket(int n) {
    if (n < 16) return n;
    return 16 + (n >= 19) + (n >= 21) + (n >= 24) + (n >= 27) + (n >= 31) + (n >= 35) + (n >= 40) + (n >= 46) + (n >= 52) + (n >= 59) + (n >= 67) + (n >= 77) + (n >= 87) + (n >= 99) + (n >= 113);
}

struct UnitDesc {
    const bf16_t* Q; const bf16_t* K; const bf16_t* V;
    int q0, j_lo, NT;
    float m_init, l_init;
    const float* bias; int bias_col;
};

template <bool SWA>
__device__ __forceinline__ void attn_unit(ALAS unsigned char* lds, const UnitDesc& u, int comp, float* T1, bf16_t* OUT, float lam, const float* subg, float oscale, const int wave_in) {
    constexpr int DV = SWA ? 128 : 256, ND0 = DV / 32, RS = DV * 2, NVP = DV / 64;
    const int wid = wave_in, lane = fresh_lane(), tid = wid * 64 + lane, c = lane & 31, hi = lane >> 5;
    const int qlo = u.q0 + wid * 32;
    unsigned voffK[2], voffV[NVP];
#pragma unroll
    for (int i = 0; i < 2; ++i) { const int row = (wid * 2 + i) * 4 + (lane >> 4), chp = lane & 15, ch = chp ^ (row & 15); voffK[i] = (unsigned)(row * PITCHB + ch * 16); }
#pragma unroll
    for (int i = 0; i < NVP; ++i) {
        int row, ch;
        if (DV == 256) { row = (wid * 4 + i) * 2 + (lane >> 5); const int chp = lane & 31; ch = chp ^ ((row & 3) << 2); }
        else           { row = (wid * 2 + i) * 4 + (lane >> 4); const int chp = lane & 15; ch = chp ^ ((row & 3) << 2); }
        voffV[i] = (unsigned)(row * PITCHB + ch * 16);
    }
#define ATT_ISSUE(tt, bf) do { const size_t ro_ = (size_t)((u.j_lo + (tt)) * KT) * PITCHB; const char* kg_ = (const char*)u.K + ro_; const char* vg_ = (const char*)u.V + ro_; \
        _Pragma("unroll") for (int i_ = 0; i_ < 2; ++i_) __builtin_amdgcn_global_load_lds((const unsigned*)(kg_ + voffK[i_]), (ALAS unsigned*)(lds + OFF_K + (bf) * K_BYTES + (wid * 2 + i_) * 1024), 16, 0, 0); \
        _Pragma("unroll") for (int i_ = 0; i_ < NVP; ++i_) __builtin_amdgcn_global_load_lds((const unsigned*)(vg_ + voffV[i_]), (ALAS unsigned*)(lds + OFF_V + (bf) * V_BYTES + (wid * NVP + i_) * 1024), 16, 0, 0); } while (0)
    ALAS float* tb = (ALAS float*)(lds + OFF_TB);
    if (tid < 128) tb[tid] = u.bias[t5_bucket(tid) * 24 + u.bias_col] * LOG2E;
    bf16x8 qf[8];
    { const bf16_t* qrow = u.Q + (size_t)(qlo + c) * PITCH + hi * 8;
#pragma unroll
      for (int d = 0; d < 8; ++d) qf[d] = *(const bf16x8*)(qrow + d * 16); }
    ATT_ISSUE(0, 0); if (u.NT > 1) ATT_ISSUE(1, 1);
    const unsigned kaddr0 = (unsigned)(OFF_K + c * 256 + ((hi ^ (c & 15)) << 4));
    const int tq = (lane & 15) >> 2, tp = lane & 3, tg1 = (lane >> 4) & 1;
    const unsigned vaddr0 = (unsigned)(OFF_V + (4 * hi + tq) * RS + ((4 * tq + 2 * tg1 + (tp >> 1)) << 4) + 8 * (tp & 1));
    ALAS float* wsf = (ALAS float*)(lds + OFF_WS) + wid * 64; ALAS float* li_l = wsf; ALAS float* al_l = wsf + 32;
    f32x16 o[ND0];
#pragma unroll
    for (int d0 = 0; d0 < ND0; ++d0) o[d0] = (f32x16){0.f, 0.f, 0.f, 0.f, 0.f, 0.f, 0.f, 0.f, 0.f, 0.f, 0.f, 0.f, 0.f, 0.f, 0.f, 0.f};
    float m_reg = u.m_init, l_reg = u.l_init;
    const int NT = u.NT;
    for (int t = 0; t < NT; ++t) {
        const int buf = t % NRING;
        if (t + 1 < NT) { if (NVP == 4) asm volatile("s_waitcnt vmcnt(6) lgkmcnt(0)" ::: "memory"); else asm volatile("s_waitcnt vmcnt(4) lgkmcnt(0)" ::: "memory"); }
        else asm volatile("s_waitcnt vmcnt(0) lgkmcnt(0)" ::: "memory");
        __builtin_amdgcn_s_barrier(); asm volatile("" ::: "memory");
        if (t + 2 < NT) ATT_ISSUE(t + 2, (t + 2) % NRING);
        const int k0t = (u.j_lo + t) * KT;
#define ATT_TR(dst, ad, off) asm volatile("ds_read_b64_tr_b16 %0, %1 offset:%2" : "=&v"(dst) : "v"(ad), "i"(off) : "memory")
#pragma unroll
        for (int h = 0; h < 2; ++h) {
            const int k0 = k0t + 32 * h;
            const int nmin = qlo - (k0 + 31), nmax = qlo + 31 - k0;
            const bool active = (nmax >= 0) && (!SWA || nmin < 128);
            if (active) {
                f32x16 p;
                const unsigned ka = kaddr0 + (unsigned)(buf * K_BYTES + h * 8192);
                {   bf16x8 kfa[4], kfb[4];
#pragma unroll
                    for (int d = 0; d < 4; ++d) kfa[d] = *(const ALAS bf16x8*)(lds + (ka ^ (unsigned)(d << 5)));
                    __builtin_amdgcn_sched_barrier(0);
#pragma unroll
                    for (int d = 0; d < 4; ++d) kfb[d] = *(const ALAS bf16x8*)(lds + (ka ^ (unsigned)((d + 4) << 5)));
                    __builtin_amdgcn_sched_barrier(0);
                    p = (f32x16){0.f, 0.f, 0.f, 0.f, 0.f, 0.f, 0.f, 0.f, 0.f, 0.f, 0.f, 0.f, 0.f, 0.f, 0.f, 0.f};
                    __builtin_amdgcn_s_setprio(1);
#pragma unroll
                    for (int d = 0; d < 4; ++d) p = __builtin_amdgcn_mfma_f32_32x32x16_bf16(kfa[d], qf[d], p, 0, 0, 0);
#pragma unroll
                    for (int d = 0; d < 4; ++d) p = __builtin_amdgcn_mfma_f32_32x32x16_bf16(kfb[d], qf[d + 4], p, 0, 0, 0);
                    __builtin_amdgcn_s_setprio(0);
                }
                float mn, alpha = 1.f, ps = 0.f;
                if (!SWA && nmin >= 113) { const float bfar = tb[127];
                    float pmax = p[0];
#pragma unroll
                    for (int r = 1; r < 16; ++r) pmax = fmaxf(pmax, p[r]);
                    pmax = fmaf(half_max(pmax), C2, bfar);
                    mn = m_reg;
                    if (!__all(pmax - m_reg <= THR)) { mn = fmaxf(m_reg, pmax); alpha = __builtin_amdgcn_exp2f(m_reg - mn); m_reg = mn; }
                    const float sh = bfar - mn;
#pragma unroll
                    for (int r = 0; r < 16; ++r) { p[r] = __builtin_amdgcn_exp2f(fmaf(p[r], C2, sh)); ps += p[r]; } }
                else { const int nb = qlo + c - k0 - 4 * hi; const unsigned W = SWA ? 128u : 0x7fffffffu; const float NEG = -__builtin_inff();
#pragma unroll
                    for (int r = 0; r < 16; ++r) { const int n0 = nb - ((r & 3) + 8 * (r >> 2));
                        const int i0 = n0 < 0 ? 0 : (n0 > 127 ? 127 : n0);
                        const float t0 = fmaf(p[r], C2, tb[i0]);
                        p[r] = ((unsigned)n0 >= W) ? NEG : t0;
                        if ((r & 3) == 3) __builtin_amdgcn_sched_barrier(0); }
                    float pmax = p[0];
#pragma unroll
                    for (int r = 1; r < 16; ++r) pmax = fmaxf(pmax, p[r]);
                    pmax = half_max(pmax);
                    mn = m_reg;
                    if (!__all(pmax - m_reg <= THR)) { mn = fmaxf(m_reg, pmax); alpha = __builtin_amdgcn_exp2f(m_reg - mn); m_reg = mn; }
#pragma unroll
                    for (int r = 0; r < 16; ++r) { p[r] = __builtin_amdgcn_exp2f(p[r] - mn); ps += p[r]; } }
                ps = half_sum(ps);
                l_reg = l_reg * alpha + ps;
                if (__any(alpha < 1.f)) { if (hi == 0) al_l[c] = alpha; asm volatile("s_waitcnt lgkmcnt(0)" ::: "memory");
#pragma unroll
                    for (int r = 0; r < 16; ++r) { const float av = al_l[crow(r, hi)];
#pragma unroll
                        for (int d0 = 0; d0 < ND0; ++d0) o[d0][r] *= av; } }
                bf16x8 pa[2];
#pragma unroll
                for (int j = 0; j < 2; ++j) { const int b = 8 * j; u32x4 w;
                    w.x = cvtpk(p[b + 0], p[b + 1]); w.y = cvtpk(p[b + 2], p[b + 3]); w.z = cvtpk(p[b + 4], p[b + 5]); w.w = cvtpk(p[b + 6], p[b + 7]);
                    pa[j] = *reinterpret_cast<bf16x8*>(&w); }
                const unsigned va = vaddr0 + (unsigned)(buf * V_BYTES);
#define ATT_TR4(L0, H0, L1, H1, dd) do { const unsigned a_ = (va ^ (unsigned)(((dd) & 3) << 6)) + (unsigned)(((dd) >> 2) * 256); \
                    if (h == 0) { ATT_TR(L0, a_, 0 * RS); ATT_TR(H0, a_, 8 * RS); ATT_TR(L1, a_, 16 * RS); ATT_TR(H1, a_, 24 * RS); } \
                    else        { ATT_TR(L0, a_, 32 * RS); ATT_TR(H0, a_, 40 * RS); ATT_TR(L1, a_, 48 * RS); ATT_TR(H1, a_, 56 * RS); } } while (0)
#define ATT_PV2(L0, H0, L1, H1, dd) do { \
                    o[dd] = __builtin_amdgcn_mfma_f32_32x32x16_bf16(pa[0], (bf16x8){L0[0], L0[1], L0[2], L0[3], H0[0], H0[1], H0[2], H0[3]}, o[dd], 0, 0, 0); \
                    o[dd] = __builtin_amdgcn_mfma_f32_32x32x16_bf16(pa[1], (bf16x8){L1[0], L1[1], L1[2], L1[3], H1[0], H1[1], H1[2], H1[3]}, o[dd], 0, 0, 0); } while (0)
                {   s16x4 al0, ah0, al1, ah1, bl0, bh0, bl1, bh1;
                    ATT_TR4(al0, ah0, al1, ah1, 0);
#pragma unroll
                    for (int d0 = 0; d0 < ND0; d0 += 2) {
                        ATT_TR4(bl0, bh0, bl1, bh1, d0 + 1);
                        asm volatile("s_waitcnt lgkmcnt(4)" ::: "memory"); __builtin_amdgcn_sched_barrier(0);
                        __builtin_amdgcn_s_setprio(1); ATT_PV2(al0, ah0, al1, ah1, d0); __builtin_amdgcn_s_setprio(0);
                        __builtin_amdgcn_sched_barrier(0);
                        if (d0 + 2 < ND0) { ATT_TR4(al0, ah0, al1, ah1, d0 + 2); asm volatile("s_waitcnt lgkmcnt(4)" ::: "memory"); }
                        else asm volatile("s_waitcnt lgkmcnt(0)" ::: "memory");
                        __builtin_amdgcn_sched_barrier(0);
                        __builtin_amdgcn_s_setprio(1); ATT_PV2(bl0, bh0, bl1, bh1, d0 + 1); __builtin_amdgcn_s_setprio(0);
                        __builtin_amdgcn_sched_barrier(0);
                    }
                }
#undef ATT_TR4
#undef ATT_PV2
            }
        }
#undef ATT_TR
    }
#undef ATT_ISSUE
    if (hi == 0) li_l[c] = l_reg;
    asm volatile("s_waitcnt lgkmcnt(0)" ::: "memory");
    if (SWA) {
        const unsigned ob = (unsigned)((qlo + 4 * hi) * MIXP + c);
#pragma unroll
        for (int r = 0; r < 16; ++r) { const float rl = 1.0f / li_l[crow(r, hi)]; const unsigned ro = ob + (unsigned)(((r & 3) + 8 * (r >> 2)) * MIXP);
#pragma unroll
            for (int d0 = 0; d0 < ND0; ++d0) { const float v = o[d0][r] * rl; const float vn = swz_xor<1>(v);
                if ((c & 1) == 0) *(unsigned*)(OUT + ro + d0 * 32) = cvtpk(v, vn); } }
    } else if (comp == 0) {
        const unsigned tbo = (unsigned)((qlo + 4 * hi) * T1P + c);
#pragma unroll
        for (int r = 0; r < 16; ++r) { const float rl = 1.0f / li_l[crow(r, hi)]; const unsigned ro = tbo + (unsigned)(((r & 3) + 8 * (r >> 2)) * T1P);
#pragma unroll
            for (int d0 = 0; d0 < ND0; ++d0) T1[ro + d0 * 32] = o[d0][r] * rl; }
    } else {
        const unsigned tbo = (unsigned)((qlo + 4 * hi) * T1P + c), ob = (unsigned)((qlo + 4 * hi) * MIXP + c);
#pragma unroll
        for (int r = 0; r < 16; ++r) { const float rl = lam / li_l[crow(r, hi)]; const unsigned ro = tbo + (unsigned)(((r & 3) + 8 * (r >> 2)) * T1P); float ss = 0.f;
            float y[ND0];
#pragma unroll
            for (int d0 = 0; d0 < ND0; ++d0) { y[d0] = T1[ro + d0 * 32] - o[d0][r] * rl; ss += y[d0] * y[d0]; }
            ss += swz_xor<1>(ss); ss += swz_xor<2>(ss); ss += swz_xor<4>(ss); ss += swz_xor<8>(ss); ss += swz_xor<16>(ss);
            const float rs = oscale / sqrtf(ss * (1.0f / 256.0f) + 1e-6f);
            const unsigned oo = ob + (unsigned)(((r & 3) + 8 * (r >> 2)) * MIXP);
#pragma unroll
            for (int d0 = 0; d0 < ND0; ++d0) { const float v = y[d0] * rs * subg[d0 * 32 + c]; const float vn = swz_xor<1>(v);
                if ((c & 1) == 0) *(unsigned*)(OUT + oo + d0 * 32) = cvtpk(v, vn); }
            asm volatile("" ::: "memory"); }
    }
    asm volatile("s_waitcnt lgkmcnt(0)" ::: "memory"); __builtin_amdgcn_s_barrier(); asm volatile("" ::: "memory");
}
}


constexpr int NWAVES = 8;
constexpr int SEQ = 16384, DM = 4096, DEPTH = 2, IN_COLS = 8704, MIXW = 4096, DFF = 11008, UPC = 2 * DFF, NMODC = 6 * DM;
constexpr int QA_OFF = 0, KA_OFF = 2048, VA_OFF = 2304, QB_OFF = 2560, KB_OFF = 4608, VB_OFF = 6656;
constexpr float EPS = 1e-6f;
constexpr size_t MiB = 1u << 20;
constexpr size_t WS_CTL = 0, CTL_ZERO_BYTES = 1 * MiB;
constexpr size_t WS_PART = 1 * MiB;
constexpr size_t WS_MOD = 3 * MiB;
constexpr size_t WS_WIN = 4 * MiB;
constexpr size_t WS_WOUT = 140 * MiB;
constexpr size_t WS_WUP = 204 * MiB;
constexpr size_t WS_WDOWN = 548 * MiB;
constexpr size_t WS_H = 720 * MiB;
constexpr size_t WS_PROJ = 848 * MiB;
constexpr size_t WS_MIX = 1120 * MiB;
constexpr size_t WS_T1 = 1248 * MiB;
constexpr size_t WS_U = 1376 * MiB;
constexpr size_t WS_ACT = 2064 * MiB;
constexpr size_t WS_END = 2408 * MiB;
constexpr int CW_BAR = 4096;
constexpr int RING_BYTES = 131072, LDSCTL_OFF = 151552, LDS_BYTES = 155648;
static_assert(att::ATT_LDS <= LDSCTL_OFF, "attention LDS map");

typedef unsigned short bf16;
typedef unsigned v4u __attribute__((ext_vector_type(4)));
typedef unsigned v2u __attribute__((ext_vector_type(2)));
typedef float f32x4 __attribute__((ext_vector_type(4)));
#define LDS_WAIT() asm volatile("s_waitcnt lgkmcnt(0)" ::: "memory")
#define VM_WAIT() asm volatile("s_waitcnt vmcnt(0)" ::: "memory")
__device__ __forceinline__ unsigned f2bf(float f) { unsigned u = __builtin_bit_cast(unsigned, f); return (u + 0x7fffu + ((u >> 16) & 1u)) >> 16; }
__device__ __forceinline__ unsigned pk2(float lo, float hi) { return f2bf(lo) | (f2bf(hi) << 16); }
__device__ __forceinline__ float bf2f(unsigned short b) { return __builtin_bit_cast(float, (unsigned)b << 16); }

__device__ __forceinline__ void transpose_item(const float* W, int K, int N, bf16* WT, LAS float* scr, int item, int lane, int gu = 0) {
    const int nblk = N / 32, kb = item / nblk, nb = item % nblk, k0 = 64 * kb, n0 = 32 * nb;
    int r0 = n0; if (gu) { const int mm = n0 < gu ? n0 : n0 - gu; r0 = (mm >> 7) * 256 + (n0 < gu ? 0 : 128) + (mm & 127); }
    float tmp[32];
#pragma unroll
    for (int i = 0; i < 32; ++i) { const int kk = 2 * i + (lane >> 5); tmp[i] = W[(size_t)(k0 + kk) * N + n0 + (lane & 31)]; }
#pragma unroll
    for (int i = 0; i < 32; ++i) { const int kk = 2 * i + (lane >> 5); scr[kk * 33 + (lane & 31)] = tmp[i]; }
    LDS_WAIT(); asm volatile("" ::: "memory");
    const int c = lane & 7;
#pragma unroll
    for (int j = 0; j < 4; ++j) { const int n = (lane >> 3) + 8 * j; const LAS float* s = scr + (8 * c) * 33 + n;
        v4u o; o.x = pk2(s[0 * 33], s[1 * 33]); o.y = pk2(s[2 * 33], s[3 * 33]); o.z = pk2(s[4 * 33], s[5 * 33]); o.w = pk2(s[6 * 33], s[7 * 33]);
        *(v4u*)(WT + (size_t)(r0 + n) * K + k0 + 8 * c) = o; }
    LDS_WAIT(); asm volatile("" ::: "memory");
}

struct Args {
    const float* in[20]; float* out; unsigned char* ws; int ph_lo, ph_hi, li, pad;
};
enum { I_X = 0, I_C, I_ADAW, I_ADAB, I_ANG, I_MNG, I_WIN, I_SINK, I_LQ1, I_LK1, I_LQ2, I_LK2, I_SUBG, I_WOUT, I_RELB, I_WUP, I_CONVW, I_CONVB, I_WDOWN, I_FING };

constexpr int N_PHASES = 19;

__device__ __forceinline__ void norm_mod_phase(LAS unsigned char* lds, const float* xin, const float* g, const float* shift, const float* scale, bf16* hout, int vcu, int G, const int wave) {
    const int lane = fresh_lane(), tid = wave * 64 + lane;
    LAS float* A = (LAS float*)lds; LAS float* B = A + DM;
    for (int j = tid; j < DM; j += NWAVES * 64) { A[j] = g[j] * (1.0f + scale[j]); B[j] = shift[j]; }
    __syncthreads();
    const int gw = vcu * NWAVES + wave, NGW = G * NWAVES;
    for (int row = gw; row < SEQ; row += NGW) {
        const f32x4* xr = (const f32x4*)(xin + (size_t)row * DM) + lane;
        f32x4 v[16]; float ss = 0.f;
#pragma unroll
        for (int i = 0; i < 16; ++i) { v[i] = xr[64 * i]; ss += (v[i].x * v[i].x + v[i].y * v[i].y) + (v[i].z * v[i].z + v[i].w * v[i].w); }
        const float rs = 1.0f / sqrtf(wave_sum(ss) * (1.0f / DM) + EPS);
        v2u* o8 = (v2u*)(hout + (size_t)row * DM) + lane;
#pragma unroll
        for (int i = 0; i < 16; ++i) { const f32x4 a = *(const LAS f32x4*)(A + 256 * i + 4 * lane), b = *(const LAS f32x4*)(B + 256 * i + 4 * lane);
            const f32x4 y = v[i] * rs * a + b; v2u w; w.x = pk2(y.x, y.y); w.y = pk2(y.z, y.w); o8[64 * i] = w; }
    }
    __syncthreads();
}

__global__ void __launch_bounds__(NWAVES * 64, 2) mega_fwd(Args args) {
    extern __shared__ __attribute__((aligned(16))) unsigned char lds_raw[];
    LAS unsigned char* lds = (LAS unsigned char*)lds_raw;
    const int wave = __builtin_amdgcn_readfirstlane((int)threadIdx.x >> 6);
    const int G = gridDim.x; const int bx = blockIdx.x;
    const int vcu = (G % 8 == 0) ? (bx % 8) * (G / 8) + bx / 8 : bx;
    unsigned char* ws = args.ws;
    unsigned* ctl = (unsigned*)(ws + WS_CTL);
    for (int u = threadIdx.x; u < (LDS_BYTES - LDSCTL_OFF) / 4; u += NWAVES * 64) ((LAS unsigned*)(lds + LDSCTL_OFF))[u] = 0u;
    __syncthreads();
    XcdBarrier bar = xcd_barrier_post(ctl + CW_BAR + (MK_PER_PHASE ? 0 : args.li) * XCD_BAR_WORDS, (volatile LAS unsigned*)(lds + LDSCTL_OFF + 64));
#if MK_PER_PHASE
    const int lo = args.ph_lo, hi = args.ph_hi;
#else
    constexpr int lo = 0, hi = N_PHASES;
#endif
#define IN(k) (lo <= (k) && (k) < hi)
#define SEAM(k) do { if (IN(k) && IN((k) + 1)) { XcdBarrier bl_ = bar; unsigned long long bp_ = (unsigned long long)bar.bar; asm volatile("" : "+s"(bp_), "+s"(bl_.x)); bl_.bar = (unsigned*)(__attribute__((address_space(1))) unsigned*)bp_;     \
        xcd_barrier(bl_); } } while (0)

    float* const xres = args.out;
    float* const part = (float*)(ws + WS_PART); float* const mod = (float*)(ws + WS_MOD);
    bf16* const Hb = (bf16*)(ws + WS_H); bf16* const PROJ = (bf16*)(ws + WS_PROJ); bf16* const MIXB = (bf16*)(ws + WS_MIX);
    float* const T1 = (float*)(ws + WS_T1); bf16* const Ub = (bf16*)(ws + WS_U); bf16* const ACT = (bf16*)(ws + WS_ACT);
    float* const HALO = (float*)(ws + WS_U + 512 * MiB); float* const FIXC = HALO + (size_t)64 * 2 * DFF; float* const FIXU = FIXC + (size_t)64 * 2 * DFF;
    const int gw = vcu * NWAVES + wave, NGW = G * NWAVES;

#ifndef NO_PRO
    if (IN(0)) for (int rep = 0; rep < 1 + ((MK_DUP >> 8) & 1); ++rep) {
        const int lane = fresh_lane(), tid = wave * 64 + lane;
        LAS float* cs = (LAS float*)(lds + 69632);
        for (int j = tid; j < DM; j += NWAVES * 64) { const float cv = args.in[I_C][j]; cs[j] = cv / (1.0f + __expf(-cv)); }
        __syncthreads();
        for (int it = gw; it < 2 * 96 * 8; it += NGW) {
            const int kc = it & 7, cb = (it >> 3) % 96, l = it / (8 * 96);
            const float* W = args.in[I_ADAW] + ((size_t)l * DM + (size_t)kc * 512) * NMODC + cb * 256 + lane * 4;
            f32x4 acc = (f32x4){0.f, 0.f, 0.f, 0.f};
            for (int k = 0; k < 512; k += 16) {
                f32x4 w[16];
#pragma unroll
                for (int i = 0; i < 16; ++i) w[i] = *(const f32x4*)(W + (size_t)(k + i) * NMODC);
#pragma unroll
                for (int i = 0; i < 16; ++i) acc += w[i] * cs[kc * 512 + k + i];
            }
            *(f32x4*)(part + ((size_t)kc * 2 + l) * NMODC + cb * 256 + lane * 4) = acc;
        }
        LAS float* scr = (LAS float*)(lds + wave * 8448);
        constexpr int I_IN = (DM / 64) * (IN_COLS / 32), I_OUT = (MIXW / 64) * (DM / 32), I_UP = (DM / 64) * (UPC / 32), I_DN = (DFF / 64) * (DM / 32), I_L = I_IN + I_OUT + I_UP + I_DN;
        for (int it = gw; it < 2 * I_L; it += NGW) {
            const int l = it / I_L; int r = it % I_L;
            if (r < I_IN) { transpose_item(args.in[I_WIN] + (size_t)l * DM * IN_COLS, DM, IN_COLS, (bf16*)(ws + WS_WIN) + (size_t)l * IN_COLS * DM, scr, r, lane); continue; } r -= I_IN;
            if (r < I_OUT) { transpose_item(args.in[I_WOUT] + (size_t)l * MIXW * DM, MIXW, DM, (bf16*)(ws + WS_WOUT) + (size_t)l * DM * MIXW, scr, r, lane); continue; } r -= I_OUT;
            if (r < I_UP) { transpose_item(args.in[I_WUP] + (size_t)l * DM * UPC, DM, UPC, (bf16*)(ws + WS_WUP) + (size_t)l * UPC * DM, scr, r, lane, DFF); continue; } r -= I_UP;
            transpose_item(args.in[I_WDOWN] + (size_t)l * DFF * DM, DFF, DM, (bf16*)(ws + WS_WDOWN) + (size_t)l * DM * DFF, scr, r, lane);
        }
        __syncthreads();
    }
#endif
    SEAM(0);
    if (IN(1)) {
        for (int j = bx * (NWAVES * 64) + wave * 64 + fresh_lane(); j < 2 * NMODC; j += G * NWAVES * 64) {
            float s = args.in[I_ADAB][j];
#pragma unroll
            for (int p = 0; p < 8; ++p) s += part[(size_t)p * 2 * NMODC + j];
            mod[j] = s;
        }
    }
    SEAM(1);

    for (int l = 0; l < DEPTH; ++l) {
        const int pb = 2 + 8 * l;
        const float* modl = mod + (size_t)l * NMODC;
        if (IN(pb + 0)) for (int rep = 0; rep < 1 + ((MK_DUP >> 0) & 1); ++rep) norm_mod_phase(lds, l == 0 ? args.in[I_X] : xres, args.in[I_ANG] + l * DM, modl + 0 * DM, modl + 1 * DM, Hb, vcu, G, wave);
        SEAM(pb + 0);
#if !defined(NO_GEMM) && !defined(NO_G1)
        if (IN(pb + 1)) {
            pg8::Gemm g{Hb, (const bf16*)(ws + WS_WIN) + (size_t)l * IN_COLS * DM, SEQ, IN_COLS, DM}; pg8::StaticOrder S; S.init(SEQ, IN_COLS, G, bx);
            pg8::EpiBf16 E{PROJ, IN_COLS};
            for (int rep = 0; rep < 1 + ((MK_DUP >> 1) & 1); ++rep) pg8::gemm_phase<pg8::EpiBf16, pg8::StaticOrder, true, true>(lds, g, S, E, wave);
        }
#endif
        SEAM(pb + 1);
        if (IN(pb + 2)) {
            const float lam_init = l == 0 ? 0.2f : 0.35550906759096927f, oscale = __builtin_bit_cast(float, __builtin_amdgcn_readfirstlane(l == 0 ? 0x3f4ccccd : 0x3f24fd5c));
            float lam;
            { const int lane = fresh_lane();
              const float* q1 = args.in[I_LQ1] + l * 128; const float* k1 = args.in[I_LK1] + l * 128; const float* q2 = args.in[I_LQ2] + l * 128; const float* k2 = args.in[I_LK2] + l * 128;
              const float s1 = wave_sum(q1[lane] * k1[lane] + q1[lane + 64] * k1[lane + 64]), s2 = wave_sum(q2[lane] * k2[lane] + q2[lane + 64] * k2[lane + 64]);
              lam = __builtin_bit_cast(float, __builtin_amdgcn_readfirstlane(__builtin_bit_cast(int, expf(s1) - expf(s2) + lam_init))); }
            const float* relb = args.in[I_RELB];
            for (int rep = 0; rep < 1 + ((MK_DUP >> 2) & 1); ++rep) {
#ifndef NO_SWA
            for (int rep2 = 0; rep2 < 1 + ((MK_DUP >> 9) & 1); ++rep2)
            for (int uu = vcu; uu < 1024; uu += G) {
                const int h = uu >> 6, qb = uu & 63, kvh = h >> 3;
                att::UnitDesc ud; ud.Q = PROJ + QA_OFF + h * 128; ud.K = PROJ + KA_OFF + kvh * 128; ud.V = PROJ + VA_OFF + kvh * 128;
                ud.q0 = qb * 256; ud.j_lo = qb == 0 ? 0 : 4 * qb - 2; ud.NT = 4 * qb + 4 - ud.j_lo;
                ud.m_init = args.in[I_SINK][l * 16 + h] * att::LOG2E; ud.l_init = 1.0f; ud.bias = relb; ud.bias_col = h;
                att::attn_unit<true>(lds, ud, 0, nullptr, MIXB + h * 128, 0.f, nullptr, 0.f, wave);
            }
#endif
#ifndef NO_DIFF
            for (int rep3 = 0; rep3 < 1 + ((MK_DUP >> 10) & 1); ++rep3)
            for (int pp = vcu; pp < 256; pp += G) {
                const int h = pp >> 5, pi = pp & 31;
                for (int s = 0; s < 4; ++s) {
                    const int qb = (s & 2) ? 63 - pi : pi, comp = s & 1;
                    att::UnitDesc ud; ud.Q = PROJ + QB_OFF + h * 256 + comp * 128; ud.K = PROJ + KB_OFF + h * 256 + comp * 128; ud.V = PROJ + VB_OFF + h * 256;
                    ud.q0 = qb * 256; ud.j_lo = 0; ud.NT = 4 * qb + 4; ud.m_init = -1e30f; ud.l_init = 0.f; ud.bias = relb; ud.bias_col = 16 + h;
                    att::attn_unit<false>(lds, ud, comp, T1 + h * 256, MIXB + 2048 + h * 256, lam, args.in[I_SUBG] + l * 256, oscale, wave);
                }
            }
#endif
            }
        }
        SEAM(pb + 2);
#if !defined(NO_GEMM) && !defined(NO_G3)
        if (IN(pb + 3)) {
            pg8::Gemm g{MIXB, (const bf16*)(ws + WS_WOUT) + (size_t)l * DM * MIXW, SEQ, DM, MIXW}; pg8::StaticOrder S; S.init(SEQ, DM, G, bx);
            if ((MK_DUP >> 3) & 1) { pg8::EpiResGate Ed{l == 0 ? args.in[I_X] : xres, (float*)Ub, DM, modl + 2 * DM}; pg8::gemm_phase<pg8::EpiResGate, pg8::StaticOrder, true, true>(lds, g, S, Ed, wave); }
            pg8::EpiResGate E{l == 0 ? args.in[I_X] : xres, xres, DM, modl + 2 * DM};
            pg8::gemm_phase<pg8::EpiResGate, pg8::StaticOrder, true, true>(lds, g, S, E, wave);
        }
#endif
        SEAM(pb + 3);
        if (IN(pb + 4)) for (int rep = 0; rep < 1 + ((MK_DUP >> 4) & 1); ++rep) norm_mod_phase(lds, xres, args.in[I_MNG] + l * DM, modl + 3 * DM, modl + 4 * DM, Hb, vcu, G, wave);
        SEAM(pb + 4);
#if !defined(NO_GEMM) && !defined(NO_G5)
        if (IN(pb + 5)) {
            pg8::Gemm g{Hb, (const bf16*)(ws + WS_WUP) + (size_t)l * UPC * DM, SEQ, UPC, DM}; pg8::StaticOrder S; S.init(SEQ, UPC, G, bx);
            pg8::EpiConvGate E{ACT, DFF, args.in[I_CONVW] + (size_t)l * 3 * DFF, args.in[I_CONVB] + (size_t)l * DFF, HALO, FIXC, FIXU, (PG8_LAS pg8::f32x4*)(lds + RING_BYTES)};
            for (int rep = 0; rep < 1 + ((MK_DUP >> 5) & 1); ++rep) pg8::gemm_phase<pg8::EpiConvGate, pg8::StaticOrder, true, true>(lds, g, S, E, wave);
        }
#endif
        SEAM(pb + 5);
#ifndef NO_CONV
        if (IN(pb + 6)) {
            const float* cw = args.in[I_CONVW] + (size_t)l * 3 * DFF;
            const int tl_ = wave * 64 + fresh_lane();
            for (int i = bx * (NWAVES * 64) + tl_; i < 63 * 2 * DFF; i += G * NWAVES * 64) {
                const int f = i % DFF, rr = (i / DFF) & 1, pm = 1 + i / (2 * DFF);
                const float h254 = HALO[((size_t)(pm - 1) * 2 + 0) * DFF + f], h255 = HALO[((size_t)(pm - 1) * 2 + 1) * DFF + f];
                float cv = FIXC[((size_t)pm * 2 + rr) * DFF + f];
                cv += rr == 0 ? cw[f] * h254 + cw[DFF + f] * h255 : cw[f] * h255;
                const float o = cv / (1.0f + __expf(-cv)) * FIXU[((size_t)pm * 2 + rr) * DFF + f];
                ACT[(size_t)(pm * 256 + rr) * DFF + f] = (bf16)f2bf(o);
            }
        }
#endif
        SEAM(pb + 6);
#if !defined(NO_GEMM) && !defined(NO_G7)
        if (IN(pb + 7)) {
            pg8::Gemm g{ACT, (const bf16*)(ws + WS_WDOWN) + (size_t)l * DM * DFF, SEQ, DM, DFF}; pg8::StaticOrder S; S.init(SEQ, DM, G, bx);
            if ((MK_DUP >> 7) & 1) { pg8::EpiResGate Ed{xres, (float*)Ub, DM, modl + 5 * DM}; pg8::gemm_phase<pg8::EpiResGate, pg8::StaticOrder, true, true>(lds, g, S, Ed, wave); }
            pg8::EpiResGate E{xres, xres, DM, modl + 5 * DM};
            pg8::gemm_phase<pg8::EpiResGate, pg8::StaticOrder, true, true>(lds, g, S, E, wave);
        }
#endif
        SEAM(pb + 7);
    }
    if (IN(18)) {
        const float* fg = args.in[I_FING];
        const int lane = fresh_lane();
        for (int row = gw; row < SEQ; row += NGW) {
            f32x4* xr = (f32x4*)(xres + (size_t)row * DM) + lane;
            f32x4 v[16]; float ss = 0.f;
#pragma unroll
            for (int i = 0; i < 16; ++i) { v[i] = xr[64 * i]; ss += (v[i].x * v[i].x + v[i].y * v[i].y) + (v[i].z * v[i].z + v[i].w * v[i].w); }
            const float rs = 1.0f / sqrtf(wave_sum(ss) * (1.0f / DM) + EPS);
#pragma unroll
            for (int i = 0; i < 16; ++i) { const f32x4 gq = *((const f32x4*)fg + 64 * i + lane); xr[64 * i] = v[i] * rs * gq; }
        }
    }
#undef IN
#undef SEAM
}


#if MK_PROBE
__device__ __forceinline__ int probe_row(int i) { const int fixed[24] = {0, 1, 2, 3, 31, 32, 33, 63, 64, 65, 127, 128, 129, 130, 255, 256, 257, 258, 4095, 4096, 8191, 8192, 16382, 16383};
    return i < 24 ? fixed[i] : (int)(((unsigned)i * 2654435761u) >> 18) & 16383; }
__device__ __forceinline__ float pbf(const bf16* p, size_t i) { return bf2f(p[i]); }
__device__ __forceinline__ void probe_fail(unsigned* flags, int bit, float got, float ref, float tol) { if (!(fabsf(got - ref) <= tol)) atomicOr(flags, 1u << bit); }
__global__ void probe_mod(const float* c, const float* adaw, const float* adab, const float* mod, unsigned* flags, int bit) {
    const int i = blockIdx.x * blockDim.x + threadIdx.x; if (i >= 2 * 512) return;
    const int l = i / 512, n = (int)(((unsigned)(i % 512) * 48u + (i % 7)) % NMODC);
    double s = adab[l * NMODC + n];
    for (int k = 0; k < DM; ++k) { const float cv = c[k]; s += (double)(cv / (1.0f + expf(-cv))) * (double)adaw[((size_t)l * DM + k) * NMODC + n]; }
    probe_fail(flags, bit, mod[l * NMODC + n], (float)s, 2e-3f + 2e-3f * fabsf((float)s));
}
__global__ void probe_norm(const float* xin, const float* g, const float* shift, const float* scale, const bf16* H, unsigned* flags, int bit) {
    __shared__ float red[256];
    const int row = probe_row(blockIdx.x); float ss = 0.f;
    for (int j = threadIdx.x; j < DM; j += 256) { const float v = xin[(size_t)row * DM + j]; ss += v * v; }
    red[threadIdx.x] = ss; __syncthreads();
    for (int o = 128; o > 0; o >>= 1) { if ((int)threadIdx.x < o) red[threadIdx.x] += red[threadIdx.x + o]; __syncthreads(); }
    const float rs = 1.0f / sqrtf(red[0] / DM + EPS);
    for (int j = threadIdx.x; j < DM; j += 256) { const float ref = xin[(size_t)row * DM + j] * rs * g[j] * (1.0f + scale[j]) + shift[j];
        probe_fail(flags, bit, pbf(H, (size_t)row * DM + j), ref, 0.01f + 0.01f * fabsf(ref)); }
}
__global__ void probe_gemm_bf16(const bf16* A, const float* W, const bf16* C, int K, int N, unsigned* flags, int bit) {
    const int row = probe_row(blockIdx.x);
    for (int s = threadIdx.x; s < 96; s += blockDim.x) {
        int col; if (s < 32) { const int edge[8] = {0, 1, 127, 128, 255, 256, N - 129, N - 1}; col = s < 8 ? edge[s] : (int)(((unsigned)(s + 97 * blockIdx.x) * 2654435761u) >> 8) % N; } else col = (int)(((unsigned)(s * 7919 + 31 * blockIdx.x) * 2246822519u) >> 8) % N;
        double acc = 0.0; for (int k = 0; k < K; ++k) acc += (double)pbf(A, (size_t)row * K + k) * (double)W[(size_t)k * N + col];
        probe_fail(flags, bit, pbf(C, (size_t)row * N + col), (float)acc, 0.03f + 0.02f * fabsf((float)acc)); }
}
__global__ void probe_gemm_res(const bf16* A, const float* W, const float* base, const float* gate, const float* out, int K, int N, unsigned* flags, int bit) {
    const int row = probe_row(blockIdx.x);
    for (int s = threadIdx.x; s < 96; s += blockDim.x) {
        int col; if (s < 8) { const int edge[8] = {0, 1, 127, 128, 255, 256, N - 129, N - 1}; col = edge[s]; } else col = (int)(((unsigned)(s * 7919 + 31 * blockIdx.x) * 2246822519u) >> 8) % N;
        double acc = 0.0; for (int k = 0; k < K; ++k) acc += (double)pbf(A, (size_t)row * K + k) * (double)W[(size_t)k * N + col];
        const float ref = base[(size_t)row * N + col] + gate[col] * (float)acc;
        probe_fail(flags, bit, out[(size_t)row * N + col], ref, 0.02f + 0.01f * fabsf(ref)); }
}
__global__ void probe_swa(const bf16* PROJ, const float* relb, const float* sinks, const bf16* MIXB, unsigned* flags, int bit) {
    __shared__ float q[128], pr[128], red[128];
    const int row = probe_row(blockIdx.x >> 4), h = blockIdx.x & 15, kvh = h >> 3, t = threadIdx.x;
    q[t] = pbf(PROJ, (size_t)row * IN_COLS + QA_OFF + h * 128 + t); __syncthreads();
    const int key = row - t; float lg = -1e30f;
    if (key >= 0) { float s = 0.f; for (int d = 0; d < 128; ++d) s += q[d] * pbf(PROJ, (size_t)key * IN_COLS + KA_OFF + kvh * 128 + d);
        lg = s * 0.08838834764831845f + relb[att::t5_bucket(t) * 24 + h]; }
    red[t] = lg; __syncthreads();
    for (int o = 64; o > 0; o >>= 1) { if (t < o) red[t] = fmaxf(red[t], red[t + o]); __syncthreads(); }
    const float mx = fmaxf(red[0], sinks[h]); __syncthreads();
    const float e = key >= 0 ? expf(lg - mx) : 0.f; pr[t] = e; red[t] = e; __syncthreads();
    for (int o = 64; o > 0; o >>= 1) { if (t < o) red[t] += red[t + o]; __syncthreads(); }
    const float den = red[0] + expf(sinks[h] - mx);
    float acc = 0.f; for (int j = 0; j < 128; ++j) { const int kk = row - j; if (kk >= 0) acc += pr[j] * pbf(PROJ, (size_t)kk * IN_COLS + VA_OFF + kvh * 128 + t); }
    const float ref = acc / den;
    probe_fail(flags, bit, pbf(MIXB, (size_t)row * MIXW + h * 128 + t), ref, 0.01f + 0.03f * fabsf(ref));
}
__global__ void probe_diff(const bf16* PROJ, const float* relb, const float* lq1, const float* lk1, const float* lq2, const float* lk2, const float* subg, float lam_init, const bf16* MIXB, float* scr_all, unsigned* flags, int bit) {
    __shared__ float q[256], red[256], red2[256];
    const int row = probe_row(blockIdx.x >> 3), h = blockIdx.x & 7, t = threadIdx.x; float* scr = scr_all + (size_t)blockIdx.x * 32768;
    q[t] = pbf(PROJ, (size_t)row * IN_COLS + QB_OFF + h * 256 + t); __syncthreads();
    float d1 = 0.f, d2 = 0.f; for (int i = 0; i < 128; ++i) { d1 += lq1[i] * lk1[i]; d2 += lq2[i] * lk2[i]; }
    const float lam = expf(d1) - expf(d2) + lam_init;
    float m1 = -1e30f, m2 = -1e30f;
    for (int k = t; k <= row; k += 256) { float s1 = 0.f, s2 = 0.f; const size_t kb = (size_t)k * IN_COLS + KB_OFF + h * 256;
        for (int d = 0; d < 128; ++d) { s1 += q[d] * pbf(PROJ, kb + d); s2 += q[128 + d] * pbf(PROJ, kb + 128 + d); }
        const int n = row - k; const float b = relb[att::t5_bucket(n > 127 ? 127 : n) * 24 + 16 + h];
        s1 = s1 * 0.08838834764831845f + b; s2 = s2 * 0.08838834764831845f + b; scr[k] = s1; scr[16384 + k] = s2; m1 = fmaxf(m1, s1); m2 = fmaxf(m2, s2); }
    red[t] = m1; red2[t] = m2; __syncthreads();
    for (int o = 128; o > 0; o >>= 1) { if (t < o) { red[t] = fmaxf(red[t], red[t + o]); red2[t] = fmaxf(red2[t], red2[t + o]); } __syncthreads(); }
    m1 = red[0]; m2 = red2[0]; __syncthreads();
    float l1 = 0.f, l2 = 0.f;
    for (int k = t; k <= row; k += 256) { const float e1 = expf(scr[k] - m1), e2 = expf(scr[16384 + k] - m2); scr[k] = e1; scr[16384 + k] = e2; l1 += e1; l2 += e2; }
    red[t] = l1; red2[t] = l2; __syncthreads();
    for (int o = 128; o > 0; o >>= 1) { if (t < o) { red[t] += red[t + o]; red2[t] += red2[t + o]; } __syncthreads(); }
    l1 = red[0]; l2 = red2[0]; __syncthreads();
    float y = 0.f; for (int k = 0; k <= row; ++k) y += (scr[k] / l1 - lam * scr[16384 + k] / l2) * pbf(PROJ, (size_t)k * IN_COLS + VB_OFF + h * 256 + t);
    red[t] = y * y; __syncthreads();
    for (int o = 128; o > 0; o >>= 1) { if (t < o) red[t] += red[t + o]; __syncthreads(); }
    const float ref = y / sqrtf(red[0] / 256.f + 1e-6f) * subg[t] * (1.0f - lam_init);
    probe_fail(flags, bit, pbf(MIXB, (size_t)row * MIXW + 2048 + h * 256 + t), ref, 0.03f + 0.03f * fabsf(ref));
}
__global__ void probe_conv(const bf16* H, const float* W  , const float* cw, const float* cb, const bf16* ACT, unsigned* flags, int bit) {
    const int row = probe_row(blockIdx.x);
    for (int s = threadIdx.x; s < 64; s += blockDim.x) {
        int col; { const int edge[12] = {0, 1, 7, 8, 31, 32, 127, 128, 129, 255, 256, DFF - 1}; col = s < 12 ? edge[s] : (int)(((unsigned)(s * 7919 + 131 * blockIdx.x) * 2246822519u) >> 8) % DFF; }
        double g[3] = {0.0, 0.0, 0.0}, up = 0.0;
        for (int j = 0; j < 3; ++j) { const int tr = row - 2 + j; if (tr >= 0) { double a = 0.0; for (int k = 0; k < DM; ++k) a += (double)pbf(H, (size_t)tr * DM + k) * (double)W[(size_t)k * UPC + col]; g[j] = a; } }
        for (int k = 0; k < DM; ++k) up += (double)pbf(H, (size_t)row * DM + k) * (double)W[(size_t)k * UPC + DFF + col];
        const float cv = cb[col] + cw[col] * (float)g[0] + cw[DFF + col] * (float)g[1] + cw[2 * DFF + col] * (float)g[2];
        const float ref = cv / (1.0f + expf(-cv)) * (float)up;
        probe_fail(flags, bit, pbf(ACT, (size_t)row * DFF + col), ref, 0.03f + 0.03f * fabsf(ref)); }
}
__global__ void probe_final(const float* xres_copy, const float* fg, const float* out, unsigned* flags, int bit) {
    __shared__ float red[256];
    const int row = probe_row(blockIdx.x); float ss = 0.f;
    for (int j = threadIdx.x; j < DM; j += 256) { const float v = xres_copy[(size_t)row * DM + j]; ss += v * v; }
    red[threadIdx.x] = ss; __syncthreads();
    for (int o = 128; o > 0; o >>= 1) { if ((int)threadIdx.x < o) red[threadIdx.x] += red[threadIdx.x + o]; __syncthreads(); }
    const float rs = 1.0f / sqrtf(red[0] / DM + EPS);
    for (int j = threadIdx.x; j < DM; j += 256) { const float ref = xres_copy[(size_t)row * DM + j] * rs * fg[j]; probe_fail(flags, bit, out[(size_t)row * DM + j], ref, 1e-3f + 1e-3f * fabsf(ref)); }
}
__global__ void probe_report(const unsigned* flags, float* out) {
    const unsigned f = *flags; if (f == 0u) return;
    int first = 0; while (!((f >> first) & 1u)) ++first;
    const int cnt = __popc(f); float V = 1000.f; for (int i = 0; i < first; ++i) V *= 10.f;
    for (int i = 0; i <= cnt; ++i) out[(size_t)i * 4099 + 5] = V;
}
#endif
extern "C" void kernel_launch(void* const* d_in, const int* in_sizes, int n_in, void* d_out, int out_size, void* d_ws, size_t ws_size, hipStream_t stream) {
    static int grid = 0;
    if (grid == 0) {
        if (n_in != 20 || in_sizes[0] != SEQ * DM || out_size != SEQ * DM || ws_size < WS_END) {
            fprintf(stderr, "kernel_launch: built for 20 inputs, x/out of %d floats, >= %zu bytes of workspace; got n_in %d, in0 %d, out %d, ws %zu; nothing launched\n", SEQ * DM, (size_t)WS_END, n_in, n_in > 0 ? in_sizes[0] : -1, out_size, ws_size); grid = -1; return; }
        int dev = 0, cus = 0, per_cu = 0;
        if (hipGetDevice(&dev) != hipSuccess || hipDeviceGetAttribute(&cus, hipDeviceAttributeMultiprocessorCount, dev) != hipSuccess) { fprintf(stderr, "kernel_launch: device query failed\n"); grid = -1; return; }
        if (hipFuncSetAttribute((const void*)mega_fwd, hipFuncAttributeMaxDynamicSharedMemorySize, LDS_BYTES) != hipSuccess) { fprintf(stderr, "kernel_launch: hipFuncSetAttribute failed\n"); grid = -1; return; }
        if (hipOccupancyMaxActiveBlocksPerMultiprocessor(&per_cu, (const void*)mega_fwd, NWAVES * 64, LDS_BYTES) != hipSuccess || per_cu < 1)
            fprintf(stderr, "kernel_launch: note: occupancy query reports %d workgroups per CU\n", per_cu);
        (void)hipGetLastError();
        grid = cus;
    }
    if (grid < 0) return;
    if (hipMemsetAsync((char*)d_ws + WS_CTL, 0, CTL_ZERO_BYTES, stream) != hipSuccess) { fprintf(stderr, "kernel_launch: memset failed\n"); return; }
    Args a{};
    for (int i = 0; i < 20; ++i) a.in[i] = (const float*)d_in[i];
    a.out = (float*)d_out; a.ws = (unsigned char*)d_ws; a.pad = 0;
#if MK_PER_PHASE
#if MK_PROBE
    constexpr int L = MK_PROBE_LAYER, NR = 40;
    unsigned char* ws = (unsigned char*)d_ws; unsigned* flags = (unsigned*)(ws + WS_CTL) + 16;
    float* xcopy = (float*)(ws + WS_END); float* dscr = (float*)(ws + WS_END + 256 * MiB);
    if (ws_size < WS_END + 256 * MiB + (size_t)NR * 8 * 32768 * 4) { fprintf(stderr, "probe: workspace too small\n"); return; }
    const float* modl = (const float*)(ws + WS_MOD) + (size_t)L * NMODC;
    const float lam_init = L == 0 ? 0.2f : 0.35550906759096927f;
    const bf16* Hb = (const bf16*)(ws + WS_H); const bf16* PROJ = (const bf16*)(ws + WS_PROJ); const bf16* MIXB = (const bf16*)(ws + WS_MIX); const bf16* Ub = (const bf16*)(ws + WS_U); const bf16* ACT = (const bf16*)(ws + WS_ACT);
    const int pb = 2 + 8 * L;
#endif
    for (int p = 0; p < N_PHASES; ++p) {
#if MK_PROBE
        if ((p == pb + 3 && L == 1) || p == pb + 7 || p == 18) hipMemcpyAsync(xcopy, d_out, (size_t)SEQ * DM * 4, hipMemcpyDeviceToDevice, stream);
#endif
        a.ph_lo = p; a.ph_hi = p + 1; a.li = 0; hipLaunchKernelGGL(mega_fwd, dim3(grid), dim3(NWAVES * 64), LDS_BYTES, stream, a);
#if MK_PROBE
        if (p == 1) hipLaunchKernelGGL(probe_mod, dim3(4), dim3(256), 0, stream, a.in[I_C], a.in[I_ADAW], a.in[I_ADAB], (const float*)(ws + WS_MOD), flags, 0);
        if (p == pb + 0) hipLaunchKernelGGL(probe_norm, dim3(NR), dim3(256), 0, stream, L == 0 ? a.in[I_X] : (const float*)d_out, a.in[I_ANG] + L * DM, modl + 0 * DM, modl + 1 * DM, Hb, flags, 1);
        if (p == pb + 1) hipLaunchKernelGGL(probe_gemm_bf16, dim3(NR), dim3(96), 0, stream, Hb, a.in[I_WIN] + (size_t)L * DM * IN_COLS, PROJ, DM, IN_COLS, flags, 2);
        if (p == pb + 2) { hipLaunchKernelGGL(probe_swa, dim3(NR * 16), dim3(128), 0, stream, PROJ, a.in[I_RELB], a.in[I_SINK] + L * 16, MIXB, flags, 3);
            hipLaunchKernelGGL(probe_diff, dim3(NR * 8), dim3(256), 0, stream, PROJ, a.in[I_RELB], a.in[I_LQ1] + L * 128, a.in[I_LK1] + L * 128, a.in[I_LQ2] + L * 128, a.in[I_LK2] + L * 128, a.in[I_SUBG] + L * 256, lam_init, MIXB, dscr, flags, 4); }
        if (p == pb + 3) hipLaunchKernelGGL(probe_gemm_res, dim3(NR), dim3(96), 0, stream, MIXB, a.in[I_WOUT] + (size_t)L * MIXW * DM, L == 0 ? a.in[I_X] : (const float*)xcopy, modl + 2 * DM, (const float*)d_out, MIXW, DM, flags, 5);
        if (p == pb + 4) hipLaunchKernelGGL(probe_norm, dim3(NR), dim3(256), 0, stream, (const float*)d_out, a.in[I_MNG] + L * DM, modl + 3 * DM, modl + 4 * DM, Hb, flags, 6);
        if (p == pb + 6) hipLaunchKernelGGL(probe_conv, dim3(NR), dim3(64), 0, stream, Hb, a.in[I_WUP] + (size_t)L * DM * UPC, a.in[I_CONVW] + (size_t)L * 3 * DFF, a.in[I_CONVB] + (size_t)L * DFF, ACT, flags, 8);
        if (p == pb + 7) hipLaunchKernelGGL(probe_gemm_res, dim3(NR), dim3(96), 0, stream, ACT, a.in[I_WDOWN] + (size_t)L * DFF * DM, (const float*)xcopy, modl + 5 * DM, (const float*)d_out, DFF, DM, flags, 9);
        if (p == 18) { hipLaunchKernelGGL(probe_final, dim3(NR), dim3(256), 0, stream, (const float*)xcopy, a.in[I_FING], (const float*)d_out, flags, 10);
            hipLaunchKernelGGL(probe_report, dim3(1), dim3(1), 0, stream, flags, (float*)d_out); }
#endif
    }
#else
    a.ph_lo = 0; a.ph_hi = N_PHASES; a.li = 0;
    hipLaunchKernelGGL(mega_fwd, dim3(grid), dim3(NWAVES * 64), LDS_BYTES, stream, a);
#endif
    const hipError_t le = hipPeekAtLastError();
    if (le != hipSuccess) fprintf(stderr, "kernel_launch: launch failed: %s\n", hipGetErrorName(le));
}
```

```cpp
#include <hip/hip_runtime.h>
#include <cstdio>
#include <cstdint>

#ifndef MK_PER_PHASE
#define MK_PER_PHASE 0
#endif

#ifndef MK_DUP
#define MK_DUP 0
#endif
#ifndef MK_BLKB
#define MK_BLKB 1
#endif
#ifndef MK_BLKA
#define MK_BLKA 0
#endif
#ifndef MK_DEFER
#define MK_DEFER 1
#endif
#ifndef MK_HALFTAIL
#define MK_HALFTAIL 0
#endif
#ifndef MK_WGM_DOWN
#define MK_WGM_DOWN 4
#endif
#ifndef MK_WGM_OUT
#define MK_WGM_OUT 8
#endif
#ifndef MK_SKEW
#define MK_SKEW 0
#endif
#ifndef MK_TMETRIC
#define MK_TMETRIC (-1)
#endif
#ifndef MK_TUNIT
#define MK_TUNIT 2
#endif
#ifndef MK_TBLOCK
#define MK_TBLOCK 0
#endif
#ifndef MK_TWAVE
#define MK_TWAVE 0
#endif
#ifndef MK_PROBE
#define MK_PROBE 0
#endif
#ifndef MK_PROBE_LAYER
#define MK_PROBE_LAYER 0
#endif
#define LAS __attribute__((address_space(3)))
template <int M> __device__ __forceinline__ float swz_xor(float v) { return __builtin_bit_cast(float, __builtin_amdgcn_ds_swizzle(__builtin_bit_cast(int, v), (M << 10) | 0x1f)); }
__device__ __forceinline__ void swap32(float& a, float& b) { asm volatile("s_nop 1\n\tv_permlane32_swap_b32 %0, %1" : "+v"(a), "+v"(b)); }
__device__ __forceinline__ float xhalf_sum(float x) { float a = x, b = x; swap32(a, b); return a + b; }
__device__ __forceinline__ float xhalf_max(float x) { float a = x, b = x; swap32(a, b); return fmaxf(a, b); }
__device__ __forceinline__ float wave_sum(float v) {
    v += swz_xor<1>(v); v += swz_xor<2>(v); v += swz_xor<4>(v); v += swz_xor<8>(v); v += swz_xor<16>(v); return xhalf_sum(v);
}
__device__ __forceinline__ int fresh_lane() { unsigned z = 0u; asm volatile("" : "+v"(z)); return (int)__builtin_amdgcn_mbcnt_hi(~0u, __builtin_amdgcn_mbcnt_lo(~0u, z)); }
namespace pg8 {
#define PG8_LAS __attribute__((address_space(3)))
typedef unsigned short bf16_t;
typedef short bf16x8 __attribute__((ext_vector_type(8)));
typedef float f32x4 __attribute__((ext_vector_type(4)));
typedef unsigned u32x4 __attribute__((ext_vector_type(4)));
constexpr int BM = 256, BK = 64, HALF = 128, HTB = HALF * BK * 2  , STAGE_BYTES = 8 * HTB, NXCD = 8, WGM = 8;

__host__ __device__ __forceinline__ int lds_byte(int r, int c) { const int st = (r >> 4) * 2 + (c >> 5), rr = r & 15, cc = c & 31, ob = rr * 64 + cc * 2; return st * 1024 + (ob ^ (((ob >> 9) & 1) << 5)); }
__host__ __device__ __forceinline__ void stage_rc(int b, int& R, int& C) { const int st = b / 1024, sb = b % 1024, swz = sb ^ (((sb >> 9) & 1) << 5); R = (st >> 1) * 16 + swz / 64; C = (st & 1) * 32 + (swz % 64) / 2; }
__host__ __device__ __forceinline__ int perm32(int rho) { const int n = rho >> 4, i = rho & 15; return 8 * (i >> 2) + 4 * n + (i & 3); }

struct Unit { int pm, pn; };
struct Gemm { const bf16_t* A; const bf16_t* Bt; int M, N, K; int blkB = 0, blkA = 0; };

struct StaticOrder {
    int nM, nN, nwg, G, c, wgm, lim;
    __host__ __device__ void init(int M, int N, int G_, int c_, int wgm_ = WGM) { nM = M / BM; nN = N / BM; nwg = nM * nN; G = G_; c = c_; wgm = wgm_; lim = nwg; }
    __host__ __device__ bool next(int i, Unit& u) const { const long L = (long)i * G + c; if (L >= lim) return false; map((int)L, u); return true; }
    __host__ __device__ void map(int L, Unit& u) const {
        int wgid = L; { const int q = nwg / NXCD, r = nwg % NXCD, xcd = wgid % NXCD, off = wgid / NXCD; wgid = (xcd < r ? xcd * (q + 1) : r * (q + 1) + (xcd - r) * q) + off; }
        const int nig = wgm * nN, gid = wgid / nig, fm = gid * wgm, gsz = (nM - fm) < wgm ? (nM - fm) : wgm;
        u.pm = fm + ((wgid % nig) % gsz); u.pn = (wgid % nig) / gsz;
    }
    __device__ __forceinline__ void a_ready(const Unit&) const {}
    __device__ __forceinline__ void done(const Unit&) const {}
};

__device__ __forceinline__ unsigned cvt_pk_bf16(float lo, float hi) { unsigned r; asm volatile("v_cvt_pk_bf16_f32 %0, %1, %2" : "=v"(r) : "v"(lo), "v"(hi)); return r; }

struct EpiBf16 {
    static constexpr bool PERM = true, AFTER_DRAIN = false;
    bf16_t* O; int ldc;
    __device__ __forceinline__ void operator()(const f32x4 (&acc)[2][2][4][2], const Unit& u, int wr, int wc, int fr, int fq) const {
        const int row0 = u.pm * BM + wr * 64 + fr; const int col0 = u.pn * BM + wc * 32 + 8 * fq;
#pragma unroll
        for (int ai = 0; ai < 2; ++ai)
#pragma unroll
            for (int m = 0; m < 4; ++m) { bf16_t* rowp = O + (size_t)(row0 + ai * HALF + m * 16) * ldc + col0;
#pragma unroll
                for (int bj = 0; bj < 2; ++bj) { const f32x4 v0 = acc[ai][bj][m][0], v1 = acc[ai][bj][m][1];
                    u32x4 w; w.x = cvt_pk_bf16(v0[0], v0[1]); w.y = cvt_pk_bf16(v0[2], v0[3]); w.z = cvt_pk_bf16(v1[0], v1[1]); w.w = cvt_pk_bf16(v1[2], v1[3]);
                    *(u32x4*)(rowp + bj * HALF) = w; } }
    }
    __device__ __forceinline__ void half_m(const f32x4 (&acc)[2][2][4][2], const Unit& u, int mh, int wr, int wc, int fr, int fq) const {
        const int row0 = u.pm * BM + mh * HALF + wr * 64 + fr; const int col0 = u.pn * BM + wc * 32 + 8 * fq;
#pragma unroll
        for (int m = 0; m < 4; ++m) { bf16_t* rowp = O + (size_t)(row0 + m * 16) * ldc + col0;
#pragma unroll
            for (int bj = 0; bj < 2; ++bj) { const f32x4 v0 = acc[0][bj][m][0], v1 = acc[0][bj][m][1];
                u32x4 w; w.x = cvt_pk_bf16(v0[0], v0[1]); w.y = cvt_pk_bf16(v0[2], v0[3]); w.z = cvt_pk_bf16(v1[0], v1[1]); w.w = cvt_pk_bf16(v1[2], v1[3]);
                *(u32x4*)(rowp + bj * HALF) = w; } }
    }
    __device__ __forceinline__ void fused(f32x4 (&)[2][2][4][2], const Unit&, int, int, int, int, PG8_LAS unsigned char*, int, int) const {}
};
struct EpiResGate {
    static constexpr bool PERM = false, AFTER_DRAIN = false;
    const float* base; float* out; int ldc; const float* gate;
    __device__ __forceinline__ void operator()(const f32x4 (&acc)[2][2][4][2], const Unit& u, int wr, int wc, int fr, int fq) const {
        const int row0 = u.pm * BM + wr * 64 + fr, col0 = u.pn * BM + wc * 32 + 4 * fq;
        f32x4 gv[2][2];
#pragma unroll
        for (int bj = 0; bj < 2; ++bj)
#pragma unroll
            for (int n = 0; n < 2; ++n) gv[bj][n] = *(const f32x4*)(gate + col0 + bj * HALF + n * 16);
#pragma unroll
        for (int ai = 0; ai < 2; ++ai)
#pragma unroll
            for (int mp = 0; mp < 4; mp += 2) {
                f32x4 bs[2][2][2];
#pragma unroll
                for (int mm = 0; mm < 2; ++mm) { const size_t off = (size_t)(row0 + ai * HALF + (mp + mm) * 16) * ldc + col0;
#pragma unroll
                    for (int bj = 0; bj < 2; ++bj)
#pragma unroll
                        for (int n = 0; n < 2; ++n) bs[mm][bj][n] = *(const f32x4*)(base + off + bj * HALF + n * 16); }
                asm volatile("" ::: "memory");
#pragma unroll
                for (int mm = 0; mm < 2; ++mm) { const size_t off = (size_t)(row0 + ai * HALF + (mp + mm) * 16) * ldc + col0;
#pragma unroll
                    for (int bj = 0; bj < 2; ++bj)
#pragma unroll
                        for (int n = 0; n < 2; ++n) *(f32x4*)(out + off + bj * HALF + n * 16) = bs[mm][bj][n] + gv[bj][n] * acc[ai][bj][mp + mm][n]; }
                asm volatile("" ::: "memory"); }
    }
    __device__ __forceinline__ void fused(f32x4 (&)[2][2][4][2], const Unit&, int, int, int, int, PG8_LAS unsigned char*, int, int) const {}
};


__device__ __forceinline__ float dpp_shr1(float old, float src) { return __builtin_bit_cast(float, __builtin_amdgcn_update_dpp(__builtin_bit_cast(int, old), __builtin_bit_cast(int, src), 0x111, 0xf, 0xf, false)); }
__device__ __forceinline__ float dpp_shr2(float old, float src) { return __builtin_bit_cast(float, __builtin_amdgcn_update_dpp(__builtin_bit_cast(int, old), __builtin_bit_cast(int, src), 0x112, 0xf, 0xf, false)); }
__device__ __forceinline__ float dpp_ror1(float src) { return __builtin_bit_cast(float, __builtin_amdgcn_update_dpp(0, __builtin_bit_cast(int, src), 0x121, 0xf, 0xf, false)); }
__device__ __forceinline__ float dpp_ror2(float src) { return __builtin_bit_cast(float, __builtin_amdgcn_update_dpp(0, __builtin_bit_cast(int, src), 0x122, 0xf, 0xf, false)); }
struct EpiConvGate {
    static constexpr bool PERM = true, AFTER_DRAIN = false;
    bf16_t* ACT; int dff; const float* cw; const float* cb; float* halo; float* fixc; float* fixu; PG8_LAS f32x4* xch; int mrows = 16384;
    __device__ __forceinline__ void operator()(const f32x4 (&acc)[2][2][4][2], const Unit& u, int wr, int wc, int fr, int fq) const {
        const int jcol = wc * 32 + 8 * fq, f0 = u.pn * 128 + jcol;
        f32x4 w0[2], w1[2], w2[2], bb[2];
#pragma unroll
        for (int n = 0; n < 2; ++n) { w0[n] = *(const f32x4*)(cw + f0 + 4 * n); w1[n] = *(const f32x4*)(cw + dff + f0 + 4 * n); w2[n] = *(const f32x4*)(cw + 2 * dff + f0 + 4 * n); bb[n] = *(const f32x4*)(cb + f0 + 4 * n); }
#pragma unroll
        for (int ai = 0; ai < 2; ++ai) if (fr >= 14) {
#pragma unroll
            for (int n = 0; n < 2; ++n) xch[((((ai * 2 + wr) * 4 + wc) * 4 + fq) * 2 + (fr - 14)) * 2 + n] = acc[ai][0][3][n]; }
        if (wr == 1 && fr >= 14) {
#pragma unroll
            for (int n = 0; n < 2; ++n) *(f32x4*)(halo + ((size_t)u.pm * 2 + (fr - 14)) * dff + f0 + 4 * n) = acc[1][0][3][n]; }
        asm volatile("s_waitcnt lgkmcnt(0)" ::: "memory"); __builtin_amdgcn_s_barrier(); asm volatile("" ::: "memory");
#pragma unroll
        for (int ai = 0; ai < 2; ++ai) {
            f32x4 p62[2], p63[2];
            const bool has_prev = (ai == 1) || (wr == 1);
            const int pai = (wr == 1) ? ai : 0, pwr = (wr == 1) ? 0 : 1;
#pragma unroll
            for (int n = 0; n < 2; ++n) { if (has_prev) { p62[n] = xch[((((pai * 2 + pwr) * 4 + wc) * 4 + fq) * 2 + 0) * 2 + n]; p63[n] = xch[((((pai * 2 + pwr) * 4 + wc) * 4 + fq) * 2 + 1) * 2 + n]; }
                                          else { p62[n] = (f32x4){0.f, 0.f, 0.f, 0.f}; p63[n] = p62[n]; } }
#pragma unroll
            for (int m = 0; m < 4; ++m) {
                const int row = u.pm * BM + ai * HALF + wr * 64 + m * 16 + fr;
                u32x4 ow; float cvv[8], upv[8];
#pragma unroll
                for (int n = 0; n < 2; ++n)
#pragma unroll
                    for (int e = 0; e < 4; ++e) {
                        const float g0 = acc[ai][0][m][n][e];
                        float o1, o2;
                        if (m == 0) { o1 = p63[n][e]; o2 = (fr == 0) ? p62[n][e] : p63[n][e]; }
                        else { o1 = dpp_ror1(acc[ai][0][m - 1][n][e]); o2 = dpp_ror2(acc[ai][0][m - 1][n][e]); }
                        const float g1 = dpp_shr1(o1, g0), g2 = dpp_shr2(o2, g0);
                        const float cv = bb[n][e] + w0[n][e] * g2 + w1[n][e] * g1 + w2[n][e] * g0;
                        cvv[4 * n + e] = cv; upv[4 * n + e] = acc[ai][1][m][n][e];
                    }
                float ov[8];
#pragma unroll
                for (int k = 0; k < 8; ++k) ov[k] = cvv[k] * __builtin_amdgcn_rcpf(1.0f + __builtin_amdgcn_exp2f(-1.4426950408889634f * cvv[k])) * upv[k];
                ow.x = cvt_pk_bf16(ov[0], ov[1]); ow.y = cvt_pk_bf16(ov[2], ov[3]); ow.z = cvt_pk_bf16(ov[4], ov[5]); ow.w = cvt_pk_bf16(ov[6], ov[7]);
                *(u32x4*)(ACT + (MK_BLKA ? ((size_t)(f0 >> 6) * mrows + row) * 64 + (f0 & 63) : (size_t)row * dff + f0)) = ow;
                if (ai == 0 && m == 0 && wr == 0 && fr < 2) {
#pragma unroll
                    for (int n = 0; n < 2; ++n) { *(f32x4*)(fixc + ((size_t)u.pm * 2 + fr) * dff + f0 + 4 * n) = (f32x4){cvv[4 * n], cvv[4 * n + 1], cvv[4 * n + 2], cvv[4 * n + 3]};
                                                  *(f32x4*)(fixu + ((size_t)u.pm * 2 + fr) * dff + f0 + 4 * n) = (f32x4){upv[4 * n], upv[4 * n + 1], upv[4 * n + 2], upv[4 * n + 3]}; } }
            }
        }
    }
    __device__ __forceinline__ void fused(f32x4 (&)[2][2][4][2], const Unit&, int, int, int, int, PG8_LAS unsigned char*, int, int) const {}
};
template <class Epi, class Sched, bool ALIGN_EPI = false, bool SP2 = false>
__device__ __forceinline__ void gemm_phase(PG8_LAS unsigned char* lds, const Gemm g, const Sched& S, const Epi& E, const int wave_in) {
    int tid_ = wave_in * 64 + fresh_lane();
    const int tid = tid_, wid = __builtin_amdgcn_readfirstlane(tid >> 6), lane = tid & 63, wr = wid >> 2, wc = wid & 3, fr = lane & 15, fq = lane >> 4;
    const int K = g.K, nt = K / BK;
    unsigned voffA[2], voffB[2];
#pragma unroll
    for (int i = 0; i < 2; ++i) { int R, C; stage_rc(tid * 16 + i * 8192, R, C); const int Rb = Epi::PERM ? ((R & ~31) + perm32(R & 31)) : R;
        voffA[i] = g.blkA ? (unsigned)(R * BK + C) * 2u : (unsigned)(R * K + C) * 2u; voffB[i] = g.blkB ? (unsigned)(Rb * BK + C) * 2u : (unsigned)(Rb * K + C) * 2u; }
    const unsigned kstep = (unsigned)(BK * 2);
    const unsigned hstep = (unsigned)HALF * (unsigned)K * 2u;
    const unsigned tstep = 2u * hstep;
    const unsigned kstepA = g.blkA ? (unsigned)g.M * (unsigned)(BK * 2) : kstep, hstepA = g.blkA ? (unsigned)(HALF * BK * 2) : hstep, tstepA = 2u * hstepA;
    const unsigned kstepB = g.blkB ? (unsigned)g.N * (unsigned)(BK * 2) : kstep, hstepB = g.blkB ? (unsigned)(HALF * BK * 2) : hstep, tstepB = 2u * hstepB;
    const __amdgpu_buffer_rsrc_t srdA = __builtin_amdgcn_make_buffer_rsrc((void*)g.A, 0, 0x7ffffff0, 0x00020000), srdB = __builtin_amdgcn_make_buffer_rsrc((void*)g.Bt, 0, 0x7ffffff0, 0x00020000);
    const unsigned ldsw = (unsigned)wid * 1024u;
    const int aoff = lds_byte(wr * 64 + fr, fq * 8), boff = lds_byte(wc * 32 + fr, fq * 8);
#define PG8_SA(b, h) (((b) * 2 + (h)) * HTB)
#define PG8_SB(b, h) ((4 + (b) * 2 + (h)) * HTB)
#define PG8_STAGE_voffA(bufoff, so_) do { _Pragma("unroll") for (int _i = 0; _i < 2; ++_i) \
        __builtin_amdgcn_raw_ptr_buffer_load_lds(srdA, (PG8_LAS void*)(lds + (bufoff) + ldsw + _i * 8192), 16, (int)voffA[_i], (int)(so_), 0, 0); } while (0)
#define PG8_STAGE_voffB(bufoff, so_) do { _Pragma("unroll") for (int _i = 0; _i < 2; ++_i) \
        __builtin_amdgcn_raw_ptr_buffer_load_lds(srdB, (PG8_LAS void*)(lds + (bufoff) + ldsw + _i * 8192), 16, (int)voffB[_i], (int)(so_), 0, 0); } while (0)
#define PG8_STAGE(bufoff, gbase, voff) PG8_STAGE_##voff(bufoff, gbase)
#define PG8_LDA(dst, b, h) do { _Pragma("unroll") for (int m = 0; m < 4; ++m) _Pragma("unroll") for (int k = 0; k < 2; ++k) dst[m][k] = *(const PG8_LAS bf16x8*)(lds + PG8_SA(b, h) + aoff + m * 2048 + k * 1024); } while (0)
#define PG8_LDB(dst, b, h) do { _Pragma("unroll") for (int n = 0; n < 2; ++n) _Pragma("unroll") for (int k = 0; k < 2; ++k) dst[n][k] = *(const PG8_LAS bf16x8*)(lds + PG8_SB(b, h) + boff + n * 2048 + k * 1024); } while (0)
#define PG8_MMA(ai, bj, At, Bt) do { __builtin_amdgcn_s_setprio(1); _Pragma("unroll") for (int m = 0; m < 4; ++m) _Pragma("unroll") for (int n = 0; n < 2; ++n) _Pragma("unroll") for (int k = 0; k < 2; ++k) \
        acc[ai][bj][m][n] = __builtin_amdgcn_mfma_f32_16x16x32_bf16(Bt[n][k], At[m][k], acc[ai][bj][m][n], 0, 0, 0); __builtin_amdgcn_s_setprio(0); } while (0)
#define PG8_WAIT_V(n) asm volatile("s_waitcnt vmcnt(" #n ")" ::: "memory")
#define PG8_WAIT_L(n) asm volatile("s_waitcnt lgkmcnt(" #n ")" ::: "memory")
#define PG8_BAR __builtin_amdgcn_s_barrier()
#define PG8_SCHED __builtin_amdgcn_sched_barrier(0)
    Unit cur, nxt; int ui = 0;
    if (!S.next(0, cur)) return;
    f32x4 acc[2][2][4][2];
#pragma unroll
    for (int a = 0; a < 2; ++a)
#pragma unroll
        for (int b = 0; b < 2; ++b)
#pragma unroll
            for (int m = 0; m < 4; ++m)
#pragma unroll
                for (int n = 0; n < 2; ++n) acc[a][b][m][n] = (f32x4){0.f, 0.f, 0.f, 0.f};
    bf16x8 At[4][2], B0[2][2], B1[2][2];
    unsigned cA = (unsigned)cur.pm * tstepA, cB = (unsigned)cur.pn * tstepB;
    S.a_ready(cur);
    if constexpr (SP2) {
        PG8_STAGE(PG8_SB(0, 0), cB, voffB); PG8_STAGE(PG8_SB(0, 1), cB + hstepB, voffB); PG8_STAGE(PG8_SA(0, 0), cA, voffA); PG8_STAGE(PG8_SA(0, 1), cA + hstepA, voffA);
        if (wr == 1) PG8_BAR;
        PG8_WAIT_V(2); PG8_BAR;
        PG8_STAGE(PG8_SB(1, 0), cB + kstepB, voffB); PG8_STAGE(PG8_SA(1, 0), cA + kstepA, voffA); PG8_STAGE(PG8_SB(1, 1), cB + hstepB + kstepB, voffB);
        PG8_WAIT_V(6); PG8_BAR;
    } else {
        PG8_STAGE(PG8_SB(0, 0), cB, voffB); PG8_STAGE(PG8_SA(0, 0), cA, voffA); PG8_STAGE(PG8_SB(0, 1), cB + hstepB, voffB); PG8_STAGE(PG8_SA(0, 1), cA + hstepA, voffA);
        if (wr == 1) PG8_BAR;
        PG8_WAIT_V(4); PG8_BAR;
        PG8_STAGE(PG8_SB(1, 0), cB + kstepB, voffB); PG8_STAGE(PG8_SA(1, 0), cA + kstepA, voffA); PG8_STAGE(PG8_SB(1, 1), cB + hstepB + kstepB, voffB);
        PG8_WAIT_V(6); PG8_BAR;
    }
    for (;;) {
        const bool has_next = S.next(ui + 1, nxt);
        const unsigned nA = has_next ? (unsigned)nxt.pm * tstepA : cA, nB = has_next ? (unsigned)nxt.pn * tstepB : cB;
        for (int t = 0; t < nt; t += 2) {
            const bool last = (t == nt - 2);
            const unsigned a1 = cA + (unsigned)(t + 1) * kstepA;
            const unsigned a2 = last ? nA : cA + (unsigned)(t + 2) * kstepA, b2 = last ? nB : cB + (unsigned)(t + 2) * kstepB;
            const unsigned a3 = a2 + kstepA, b3 = b2 + kstepB;
            if (last && has_next) S.a_ready(nxt);
            if constexpr (SP2) {
            PG8_LDB(B0, 0, 0); PG8_LDB(B1, 0, 1); PG8_SCHED; PG8_LDA(At, 0, 0); PG8_STAGE(PG8_SA(1, 1), a1 + hstepA, voffA);
            PG8_WAIT_V(8); PG8_WAIT_L(0); PG8_BAR; PG8_MMA(0, 0, At, B0); PG8_MMA(0, 1, At, B1); PG8_BAR; PG8_SCHED;
            PG8_LDA(At, 0, 1); PG8_STAGE(PG8_SB(0, 0), b2, voffB); PG8_STAGE(PG8_SB(0, 1), b2 + hstepB, voffB); PG8_STAGE(PG8_SA(0, 0), a2, voffA);
            PG8_WAIT_V(8); PG8_WAIT_L(0); PG8_BAR; PG8_MMA(1, 0, At, B0); PG8_MMA(1, 1, At, B1); PG8_BAR; PG8_SCHED;
            PG8_LDB(B0, 1, 0); PG8_LDB(B1, 1, 1); PG8_SCHED; PG8_LDA(At, 1, 0); PG8_STAGE(PG8_SA(0, 1), a2 + hstepA, voffA);
            PG8_WAIT_V(8); PG8_WAIT_L(0); PG8_BAR; PG8_MMA(0, 0, At, B0); PG8_MMA(0, 1, At, B1); PG8_BAR; PG8_SCHED;
            PG8_LDA(At, 1, 1); PG8_STAGE(PG8_SB(1, 0), b3, voffB); PG8_STAGE(PG8_SB(1, 1), b3 + hstepB, voffB); PG8_STAGE(PG8_SA(1, 0), a3, voffA);
            PG8_WAIT_V(8); PG8_WAIT_L(0); PG8_BAR; PG8_MMA(1, 0, At, B0); PG8_MMA(1, 1, At, B1); PG8_BAR; PG8_SCHED;
            } else {
            PG8_LDB(B0, 0, 0); PG8_SCHED; PG8_LDA(At, 0, 0); PG8_STAGE(PG8_SA(1, 1), a1 + hstepA, voffA);
            PG8_WAIT_L(8); PG8_BAR; PG8_WAIT_L(0); PG8_MMA(0, 0, At, B0); PG8_BAR; PG8_SCHED;
            PG8_LDB(B1, 0, 1); PG8_STAGE(PG8_SB(0, 0), b2, voffB);
            PG8_BAR; PG8_WAIT_L(0); PG8_MMA(0, 1, At, B1); PG8_BAR;
            PG8_LDA(At, 0, 1); PG8_STAGE(PG8_SA(0, 0), a2, voffA);
            PG8_BAR; PG8_WAIT_L(0); PG8_MMA(1, 0, At, B0); PG8_BAR; PG8_SCHED;
            PG8_STAGE(PG8_SB(0, 1), b2 + hstepB, voffB);
            PG8_WAIT_V(6); PG8_BAR; PG8_MMA(1, 1, At, B1); PG8_BAR;
            PG8_LDB(B0, 1, 0); PG8_SCHED; PG8_LDA(At, 1, 0); PG8_STAGE(PG8_SA(0, 1), a2 + hstepA, voffA);
            PG8_WAIT_L(8); PG8_BAR; PG8_WAIT_L(0); PG8_MMA(0, 0, At, B0); PG8_BAR; PG8_SCHED;
            PG8_LDB(B1, 1, 1); PG8_STAGE(PG8_SB(1, 0), b3, voffB);
            PG8_BAR; PG8_WAIT_L(0); PG8_MMA(0, 1, At, B1); PG8_BAR;
            PG8_LDA(At, 1, 1); PG8_STAGE(PG8_SA(1, 0), a3, voffA);
            PG8_BAR; PG8_WAIT_L(0); PG8_MMA(1, 0, At, B0); PG8_BAR; PG8_SCHED;
            PG8_STAGE(PG8_SB(1, 1), b3 + hstepB, voffB);
            PG8_WAIT_V(6); PG8_BAR; PG8_MMA(1, 1, At, B1); PG8_BAR;
            }
        }
        if constexpr (ALIGN_EPI) { if (wr == 0) PG8_BAR; }
        if constexpr (!Epi::AFTER_DRAIN) { E(acc, cur, wr, wc, fr, fq); S.done(cur); }
        if (!has_next) break;
#pragma unroll
        for (int a = 0; a < 2; ++a)
#pragma unroll
            for (int b = 0; b < 2; ++b)
#pragma unroll
                for (int m = 0; m < 4; ++m)
#pragma unroll
                    for (int n = 0; n < 2; ++n) acc[a][b][m][n] = (f32x4){0.f, 0.f, 0.f, 0.f};
        cur = nxt; cA = nA; cB = nB; ++ui;
        if constexpr (ALIGN_EPI) { if (wr == 1) PG8_BAR; }
    }
    PG8_WAIT_V(0);
    if constexpr (!ALIGN_EPI) { if (wr == 0) PG8_BAR; }
    PG8_BAR;
    if constexpr (Epi::AFTER_DRAIN) { E.fused(acc, cur, wr, wc, fr, fq, lds, wid, lane); S.done(cur); }
#undef PG8_SA
#undef PG8_SB
#undef PG8_STAGE
#undef PG8_STAGE_voffA
#undef PG8_STAGE_voffB
#undef PG8_LDA
#undef PG8_LDB
#undef PG8_MMA
#undef PG8_WAIT_V
#undef PG8_WAIT_L
#undef PG8_BAR
#undef PG8_SCHED
}
template <class Epi>
__device__ __forceinline__ void gemm_half_unit(PG8_LAS unsigned char* lds, const Gemm g, const Unit cur, const int mh, const Epi& E, const int wave_in) {
    int tid_ = wave_in * 64 + fresh_lane();
    const int tid = tid_, wid = __builtin_amdgcn_readfirstlane(tid >> 6), lane = tid & 63, wr = wid >> 2, wc = wid & 3, fr = lane & 15, fq = lane >> 4;
    const int K = g.K, nt = K / BK;
    unsigned voffA[2], voffB[2];
#pragma unroll
    for (int i = 0; i < 2; ++i) { int R, C; stage_rc(tid * 16 + i * 8192, R, C); const int Rb = Epi::PERM ? ((R & ~31) + perm32(R & 31)) : R;
        voffA[i] = (unsigned)(R * K + C) * 2u; voffB[i] = (unsigned)(Rb * K + C) * 2u; }
    const size_t kstep = (size_t)(BK * 2), hstep = (size_t)HALF * K * 2, tstep = 2 * hstep;
    const unsigned ldsw = (unsigned)wid * 1024u;
    const int aoff = lds_byte(wr * 64 + fr, fq * 8), boff = lds_byte(wc * 32 + fr, fq * 8);
#define PGH_SA(b) (((b) * 2) * HTB)
#define PGH_SB(b, h) ((4 + (b) * 2 + (h)) * HTB)
#define PGH_STAGE(bufoff, gbase, voff) do { _Pragma("unroll") for (int _i = 0; _i < 2; ++_i) \
        __builtin_amdgcn_global_load_lds((const unsigned*)((const char*)(gbase) + (voff)[_i]), (PG8_LAS unsigned*)(lds + (bufoff) + ldsw + _i * 8192), 16, 0, 0); } while (0)
#define PGH_FILL(b, tt) do { PGH_STAGE(PGH_SB(b, 0), cB + (size_t)(tt) * kstep, voffB); PGH_STAGE(PGH_SB(b, 1), cB + hstep + (size_t)(tt) * kstep, voffB); PGH_STAGE(PGH_SA(b), cA + (size_t)(tt) * kstep, voffA); } while (0)
#define PGH_MMA(bj, Bt) do { __builtin_amdgcn_s_setprio(1); _Pragma("unroll") for (int m = 0; m < 4; ++m) _Pragma("unroll") for (int n = 0; n < 2; ++n) _Pragma("unroll") for (int k = 0; k < 2; ++k) \
        acc[0][bj][m][n] = __builtin_amdgcn_mfma_f32_16x16x32_bf16(Bt[n][k], At[m][k], acc[0][bj][m][n], 0, 0, 0); __builtin_amdgcn_s_setprio(0); } while (0)
#define PGH_TILE(b, tt) do { \
        _Pragma("unroll") for (int n = 0; n < 2; ++n) _Pragma("unroll") for (int k = 0; k < 2; ++k) { B0[n][k] = *(const PG8_LAS bf16x8*)(lds + PGH_SB(b, 0) + boff + n * 2048 + k * 1024); B1[n][k] = *(const PG8_LAS bf16x8*)(lds + PGH_SB(b, 1) + boff + n * 2048 + k * 1024); } \
        _Pragma("unroll") for (int m = 0; m < 4; ++m) _Pragma("unroll") for (int k = 0; k < 2; ++k) At[m][k] = *(const PG8_LAS bf16x8*)(lds + PGH_SA(b) + aoff + m * 2048 + k * 1024); \
        asm volatile("s_waitcnt lgkmcnt(0)" ::: "memory"); __builtin_amdgcn_s_barrier(); __builtin_amdgcn_sched_barrier(0); \
        if ((tt) + 2 < nt) PGH_FILL(b, (tt) + 2); \
        PGH_MMA(0, B0); PGH_MMA(1, B1); __builtin_amdgcn_sched_barrier(0); \
        if ((tt) + 2 < nt) asm volatile("s_waitcnt vmcnt(6)" ::: "memory"); else asm volatile("s_waitcnt vmcnt(0)" ::: "memory"); \
        __builtin_amdgcn_s_barrier(); __builtin_amdgcn_sched_barrier(0); } while (0)
    f32x4 acc[2][2][4][2];
#pragma unroll
    for (int bq = 0; bq < 2; ++bq)
#pragma unroll
        for (int m = 0; m < 4; ++m)
#pragma unroll
            for (int n = 0; n < 2; ++n) { acc[0][bq][m][n] = (f32x4){0.f, 0.f, 0.f, 0.f}; acc[1][bq][m][n] = (f32x4){0.f, 0.f, 0.f, 0.f}; }
    bf16x8 At[4][2], B0[2][2], B1[2][2];
    const char* cA = (const char*)g.A + (size_t)cur.pm * tstep + (size_t)mh * hstep; const char* cB = (const char*)g.Bt + (size_t)cur.pn * tstep;
    PGH_FILL(0, 0); PGH_FILL(1, 1);
    asm volatile("s_waitcnt vmcnt(6)" ::: "memory"); __builtin_amdgcn_s_barrier(); __builtin_amdgcn_sched_barrier(0);
    for (int t = 0; t < nt; t += 2) { PGH_TILE(0, t); PGH_TILE(1, t + 1); }
    E.half_m(acc, cur, mh, wr, wc, fr, fq);
    asm volatile("s_waitcnt lgkmcnt(0)" ::: "memory"); __builtin_amdgcn_s_barrier();
#undef PGH_SA
#undef PGH_SB
#undef PGH_STAGE
#undef PGH_FILL
#undef PGH_MMA
#undef PGH_TILE
}
}
#define XB_TMO      128
#define XB_XCNT(j)  (256  + 64 * (j))
#define XB_XSUB(j)  (1280 + 64 * (j))
#define XB_XGEN(j)  (2304 + 64 * (j))
#define XB_TOP      3328
#define XB_TOPGEN   3392
#define XCD_BAR_WORDS 3456
#define XB_SPIN_CAP (1u << 18)

__device__ __forceinline__ unsigned xb_ld(unsigned* p)              { return __hip_atomic_load(p, __ATOMIC_RELAXED, __HIP_MEMORY_SCOPE_AGENT); }
__device__ __forceinline__ unsigned xb_add(unsigned* p, unsigned v) { return __hip_atomic_fetch_add(p, v, __ATOMIC_RELAXED, __HIP_MEMORY_SCOPE_AGENT); }
__device__ __forceinline__ unsigned xb_xcc_id() { return (unsigned)__builtin_amdgcn_s_getreg((3 << 11) | 20) & 0xFu; }
#define XB_SPIN(cond, bar) do { unsigned _sp = 0; while (cond) { __builtin_amdgcn_s_sleep(1); \
    if ((++_sp & 255u) == 0u) { if (xb_ld(&(bar)[XB_TMO])) break; if (_sp > XB_SPIN_CAP) { atomicAdd(&(bar)[XB_TMO], 1u); break; } } } } while (0)

struct XcdBarrier {
    unsigned* bar; unsigned x;
    volatile LAS unsigned* st;
    bool t0;
};

__device__ __forceinline__ XcdBarrier xcd_barrier_post(unsigned* bar, volatile LAS unsigned* st) {
    XcdBarrier b; b.bar = bar; b.x = xb_xcc_id(); b.st = st; b.t0 = (threadIdx.x == 0);
    if (b.t0) (void)xb_add(&bar[XB_XCNT(b.x)], 1u);
    return b;
}
__device__ __forceinline__ void xcd_barrier_complete(unsigned* bar, unsigned x, unsigned& nloc, unsigned& nx) {
    const unsigned G = gridDim.x * gridDim.y * gridDim.z;
    unsigned sum, cnt, mine, sp = 0u;
    for (;;) {
        sum = 0u; cnt = 0u; mine = 0u;
#pragma unroll
        for (unsigned j = 0; j < 16; ++j) { const unsigned c = xb_ld(&bar[XB_XCNT(j)]); sum += c; cnt += (c > 0u) ? 1u : 0u; mine = (j == x) ? c : mine; }
        if (sum == G) break;
        __builtin_amdgcn_s_sleep(1);
        if ((++sp & 255u) == 0u) { if (xb_ld(&bar[XB_TMO])) break; if (sp > XB_SPIN_CAP) { atomicAdd(&bar[XB_TMO], 1u); break; } }
    }
    nloc = mine > 0u ? mine : 1u; nx = cnt > 0u ? cnt : 1u;
}

__device__ __forceinline__ void xcd_barrier(const XcdBarrier& b) {
    asm volatile("s_waitcnt vmcnt(0)" ::: "memory");
    __syncthreads();
    if (b.t0) {
        unsigned* bar = b.bar;
        __builtin_amdgcn_s_waitcnt(0);
        unsigned nloc = b.st[0], nx = b.st[1];
        if (nloc == 0u) { xcd_barrier_complete(bar, b.x, nloc, nx); b.st[0] = nloc; b.st[1] = nx; }
        const unsigned old = xb_add(&bar[XB_XSUB(b.x)], 1u);
        const unsigned gen = old / nloc;
        if (old + 1u == (gen + 1u) * nloc) {
            __builtin_amdgcn_fence(__ATOMIC_RELEASE, "agent");
            asm volatile("s_waitcnt vmcnt(0)" ::: "memory");
            const unsigned og = xb_add(&bar[XB_TOP], 1u);
            const unsigned tg = og / nx;
            if (og + 1u == (tg + 1u) * nx) xb_add(&bar[XB_TOPGEN], 1u);
            else XB_SPIN(xb_ld(&bar[XB_TOPGEN]) == tg, bar);
            __builtin_amdgcn_fence(__ATOMIC_ACQUIRE, "agent");
            xb_add(&bar[XB_XGEN(b.x)], 1u);
            asm volatile("s_waitcnt vmcnt(0)" ::: "memory");
        } else {
            XB_SPIN(xb_ld(&bar[XB_XGEN(b.x)]) == gen, bar);
            __builtin_amdgcn_fence(__ATOMIC_ACQUIRE, "agent");
            asm volatile("s_waitcnt vmcnt(0)" ::: "memory");
        }
    }
    __syncthreads();
}

namespace att {
typedef unsigned short bf16_t;
typedef short bf16x8 __attribute__((ext_vector_type(8)));
typedef short s16x4 __attribute__((ext_vector_type(4)));
typedef float f32x16 __attribute__((ext_vector_type(16)));
typedef float f32x4 __attribute__((ext_vector_type(4)));
typedef unsigned u32x4 __attribute__((ext_vector_type(4)));
#define ALAS __attribute__((address_space(3)))

constexpr int KT = 64, PITCH = 8704, PITCHB = PITCH * 2, QBLK = 256, MIXP = 4096, T1P = 2048;
constexpr int K_BYTES = KT * 256;
constexpr int V_BYTES = KT * 512;
constexpr int NRING = 3;
constexpr int OFF_K = 0, OFF_V = NRING * K_BYTES, OFF_TB = OFF_V + NRING * V_BYTES, OFF_WS = OFF_TB + 512, OFF_PF = OFF_WS + 8 * 256, ATT_LDS = OFF_PF + 256;
constexpr float LOG2E = 1.4426950408889634f;
constexpr float C2 = 0.12751743082459868f;
#ifndef ATT_EXP
#define ATT_EXP 3
#endif
#if ATT_EXP == 3 || ATT_EXP == 4
#define ATT_PRIO_UP() do { } while (0)
#define ATT_PRIO_DN() do { } while (0)
#else
#define ATT_PRIO_UP() __builtin_amdgcn_s_setprio(1)
#define ATT_PRIO_DN() __builtin_amdgcn_s_setprio(0)
#endif
#ifndef ATT_DMAPV
#define ATT_DMAPV 0
#endif
#ifndef ATT_FASTFAR
#define ATT_FASTFAR 1
#endif
#ifndef ATT_BUFDMA
#define ATT_BUFDMA 1
#endif
#ifndef ATT_STAG
#define ATT_STAG 0
#endif
#ifndef ATT_PF
#define ATT_PF 0
#endif
#ifndef ATT_MIDBAR
#define ATT_MIDBAR 0
#endif
#ifndef ATT_LAG
#define ATT_LAG 0
#endif
#ifndef ATT_FLIP
#define ATT_FLIP 1
#endif
constexpr float THR = 8.f;

__device__ __forceinline__ int crow(int r, int hi) { return (r & 3) + 8 * (r >> 2) + 4 * hi; }
__device__ __forceinline__ unsigned cvtpk(float lo, float hi) { unsigned r; asm volatile("v_cvt_pk_bf16_f32 %0, %1, %2" : "=v"(r) : "v"(lo), "v"(hi)); return r; }
__device__ __forceinline__ float half_max(float x) { return xhalf_max(x); }
__device__ __forceinline__ float half_sum(float x) { return xhalf_sum(x); }
__device__ __forceinline__ int t5_bucket(int n) {
    if (n < 16) return n;
    return 16 + (n >= 19) + (n >= 21) + (n >= 24) + (n >= 27) + (n >= 31) + (n >= 35) + (n >= 40) + (n >= 46) + (n >= 52) + (n >= 59) + (n >= 67) + (n >= 77) + (n >= 87) + (n >= 99) + (n >= 113);
}

struct UnitDesc {
    const bf16_t* Q; const bf16_t* K; const bf16_t* V;
    int q0, j_lo, NT;
    float m_init, l_init;
    const float* bias; int bias_col;
    const float* sinks;
};

template <bool SWA>
__device__ __forceinline__ void attn_unit(ALAS unsigned char* lds, const UnitDesc& u, int comp, float* T1, bf16_t* OUT, float lam, const float* subg, float oscale, const int wave_in, float* tm_out = nullptr) {
    constexpr int DV = SWA ? 128 : 256, ND0 = DV / 32, RS = DV * 2, NVP = DV / 64;
    const int wid = wave_in, lane = fresh_lane(), tid = wid * 64 + lane, c = lane & 31, hi = lane >> 5;
    const int qlo = SWA ? u.q0 : u.q0 + wid * 32;
    const int hoff = SWA ? wid * 128 : 0;
#define ATT_ISSUE_KR(tt, bf, i0, i1) do { const char* kg_ = (const char*)u.K + (size_t)((u.j_lo + (tt)) * KT) * PITCHB; const int ln_ = fresh_lane(); \
        _Pragma("unroll") for (int i_ = 0; i_ < 2; ++i_) if (i_ >= (i0) && i_ < (i1)) { const int row_ = (wid * 2 + i_) * 4 + (ln_ >> 4), ch_ = (ln_ & 15) ^ (row_ & 15); \
            __builtin_amdgcn_global_load_lds((const unsigned*)(kg_ + (unsigned)(row_ * PITCHB + ch_ * 16)), (ALAS unsigned*)(lds + OFF_K + (bf) * K_BYTES + (wid * 2 + i_) * 1024), 16, 0, 0); } } while (0)
#define ATT_ISSUE_K(tt, bf) ATT_ISSUE_KR(tt, bf, 0, 2)
#define ATT_ISSUE_V(tt, bf, i0, i1) do { const char* vg_ = (const char*)u.V + (size_t)((u.j_lo + (tt)) * KT) * PITCHB; const int ln_ = fresh_lane(); \
        _Pragma("unroll") for (int i_ = 0; i_ < NVP; ++i_) if (i_ >= (i0) && i_ < (i1)) { \
            const int row_ = (DV == 256) ? (wid * 4 + i_) * 2 + (ln_ >> 5) : (wid * 2 + i_) * 4 + (ln_ >> 4); const int ch_ = ((DV == 256) ? (ln_ & 31) : (ln_ & 15)) ^ ((row_ & 3) << 2); \
            __builtin_amdgcn_global_load_lds((const unsigned*)(vg_ + (unsigned)(row_ * PITCHB + ch_ * 16)), (ALAS unsigned*)(lds + OFF_V + (bf) * V_BYTES + (wid * NVP + i_) * 1024), 16, 0, 0); } } while (0)
#define ATT_ISSUE(tt, bf) do { ATT_ISSUE_K(tt, bf); ATT_ISSUE_V(tt, bf, 0, NVP); } while (0)
#define ATT_PIECE(tt, bf, idx) do { if ((idx) < 2) ATT_ISSUE_KR(tt, bf, (idx), (idx) + 1); else ATT_ISSUE_V(tt, bf, (idx) - 2, (idx) - 1); } while (0)
#define ATT_ISSUE_HALF(tt, bf, hh) do { if ((hh) == 0) { ATT_ISSUE_K(tt, bf); ATT_ISSUE_V(tt, bf, 0, NVP / 4); } else { ATT_ISSUE_V(tt, bf, NVP / 4, NVP); } } while (0)
#define ATT_RAWLD(srd_, ldsoff_, vo_, so_) __builtin_amdgcn_raw_ptr_buffer_load_lds(srd_, (ALAS void*)(lds + (ldsoff_)), 16, (int)(vo_), (int)(so_), 0, 0)
#define ATT_BISSUE(tt, bf, hh) do { const unsigned so_ = (unsigned)((u.j_lo + (tt)) * KT) * (unsigned)PITCHB; const unsigned vv_ = vv0, vk_ = vk0; \
        if ((hh) != 1) { \
            ATT_RAWLD(srdK, OFF_K + (bf) * K_BYTES + (wid * 2) * 1024, vk_, so_); ATT_RAWLD(srdK, OFF_K + (bf) * K_BYTES + (wid * 2 + 1) * 1024, vk_ ^ 64u, so_ + 4u * PITCHB); \
            } \
        if ((hh) != 0) { ATT_RAWLD(srdV, OFF_V + (bf) * V_BYTES + (wid * 4) * 1024, vv_, so_); ATT_RAWLD(srdV, OFF_V + (bf) * V_BYTES + (wid * 4 + 1) * 1024, vv_ ^ 128u, so_ + 2u * PITCHB); ATT_RAWLD(srdV, OFF_V + (bf) * V_BYTES + (wid * 4 + 2) * 1024, vv_, so_ + 4u * PITCHB); \
            ATT_RAWLD(srdV, OFF_V + (bf) * V_BYTES + (wid * 4 + 3) * 1024, vv_ ^ 128u, so_ + 6u * PITCHB); } } while (0)
    unsigned vk0, vv0;
    { const int rk_ = wid * 8 + (lane >> 4), rv_ = wid * 8 + (lane >> 5); vk0 = (unsigned)(rk_ * PITCHB + (((lane & 15) ^ (rk_ & 15)) << 4)); vv0 = (unsigned)(rv_ * PITCHB + (((lane & 31) ^ ((rv_ & 3) << 2)) << 4)); }
    __amdgpu_buffer_rsrc_t srdK = __builtin_amdgcn_make_buffer_rsrc((void*)u.K, 0, 0x7ffffff0, 0x00020000), srdV = __builtin_amdgcn_make_buffer_rsrc((void*)u.V, 0, 0x7ffffff0, 0x00020000);
#define ATT_PREFETCH(tt) do { const int ln_ = fresh_lane(); int tp_ = (tt) + (wid >= 6 ? 1 : 0); tp_ = tp_ < NT ? tp_ : NT - 1; \
        const char* pb_ = (const char*)((wid >= 2 && wid < 6) ? u.V : u.K) + (size_t)((u.j_lo + tp_) * KT) * PITCHB; \
        const int li_ = ((wid >= 2 && wid < 6) ? (wid - 2) : (wid & 1)) * 64 + ln_; \
        const unsigned po_ = (wid >= 2 && wid < 6) ? (unsigned)((li_ >> 2) * PITCHB + (li_ & 3) * 128) : (unsigned)((li_ >> 1) * PITCHB + (li_ & 1) * 128); \
        __builtin_amdgcn_global_load_lds((const unsigned*)(pb_ + po_), (ALAS unsigned*)(lds + OFF_PF), 4, 0, 0); } while (0)
    ALAS float* tb = SWA ? (ALAS float*)(lds + OFF_V + 16384 + wid * 512) : (ALAS float*)(lds + OFF_TB);
    if (SWA) { tb[lane] = u.bias[t5_bucket(lane) * 24 + u.bias_col + wid] * LOG2E; tb[lane + 64] = u.bias[t5_bucket(lane + 64) * 24 + u.bias_col + wid] * LOG2E; }
    else if (tid < 128) tb[tid] = u.bias[t5_bucket(tid) * 24 + u.bias_col] * LOG2E;
    bf16x8 qf[8];
    { const bf16_t* qrow = u.Q + hoff + (size_t)(qlo + c) * PITCH + hi * 8;
#pragma unroll
      for (int d = 0; d < 8; ++d) qf[d] = *(const bf16x8*)(qrow + d * 16); }
    if (!SWA && ATT_BUFDMA) { ATT_BISSUE(0, 0, 2); if (u.NT > 1) ATT_BISSUE(1, 1, 2); } else { ATT_ISSUE(0, 0); if (u.NT > 1) ATT_ISSUE(1, 1); }
    const unsigned kaddr0 = (unsigned)(OFF_K + c * 256 + ((hi ^ (c & 15)) << 4));
    const int tq = (lane & 15) >> 2, tp = lane & 3, tg1 = (lane >> 4) & 1;
    const unsigned vaddr0 = (unsigned)(OFF_V + (4 * hi + tq) * RS + ((4 * tq + 2 * tg1 + (tp >> 1)) << 4) + 8 * (tp & 1));
    ALAS float* wsf = (ALAS float*)(lds + OFF_WS) + wid * 64; ALAS float* li_l = wsf; ALAS float* al_l = wsf + 32;
    f32x16 o[ND0];
#pragma unroll
    for (int d0 = 0; d0 < ND0; ++d0) o[d0] = (f32x16){0.f, 0.f, 0.f, 0.f, 0.f, 0.f, 0.f, 0.f, 0.f, 0.f, 0.f, 0.f, 0.f, 0.f, 0.f, 0.f};
    float m_reg = SWA ? u.sinks[wid] * LOG2E : u.m_init, l_reg = u.l_init;
    constexpr float CQ = SWA ? C2 : 1.0f;
    f32x16 negm = (f32x16){0.f, 0.f, 0.f, 0.f, 0.f, 0.f, 0.f, 0.f, 0.f, 0.f, 0.f, 0.f, 0.f, 0.f, 0.f, 0.f}; bool have_ref = false;
    const int NT = u.NT;
#if MK_TMETRIC >= 0
    const bool tmeas = !SWA && wid == MK_TWAVE && NT >= 200 && comp == 0; unsigned long long tprev = clock64(); unsigned tacc[6] = {0u, 0u, 0u, 0u, 0u, 0u};
#define TS(i) do { if (tmeas) { const unsigned long long tn_ = clock64(); tacc[i] += (unsigned)(tn_ - tprev); tprev = tn_; } } while (0)
#else
#define TS(i) do { } while (0)
#endif
#if ATT_EXP == 4
    if (wid >= 4) __builtin_amdgcn_s_setprio(1);
#endif
    const unsigned ldsb = (unsigned)(unsigned long long)lds;
    bf16x8 kf[8];
#define ATT_LDK(bf_, hh_) do { unsigned kb_ = kaddr0; asm volatile("" : "+v"(kb_));     \
        const unsigned ka_ = kb_ + (unsigned)((bf_) * K_BYTES + (hh_) * 8192) + ldsb;     \
        _Pragma("unroll") for (int d_ = 0; d_ < 8; ++d_) kf[d_] = *(const ALAS bf16x8*)(unsigned)(ka_ ^ (unsigned)(d_ << 5)); __builtin_amdgcn_sched_barrier(0); } while (0)
    const bool lagw = !SWA && ATT_LAG && wid >= 4;
    const int wslot = wid % 6;
    constexpr bool MIDB = !SWA && ATT_MIDBAR && !ATT_LAG;
    if (MIDB) { if (NT > 1) asm volatile("s_waitcnt vmcnt(6) lgkmcnt(0)" ::: "memory"); else asm volatile("s_waitcnt vmcnt(0) lgkmcnt(0)" ::: "memory");
        __builtin_amdgcn_s_barrier(); asm volatile("" ::: "memory"); ATT_LDK(0, 0); }
    if (!SWA && ATT_LAG) { if (NT > 1) asm volatile("s_waitcnt vmcnt(6) lgkmcnt(0)" ::: "memory"); else asm volatile("s_waitcnt vmcnt(0) lgkmcnt(0)" ::: "memory");
        __builtin_amdgcn_s_barrier(); asm volatile("" ::: "memory");
        if (lagw) ATT_LDK(0, 0); }
    for (int t = 0; t < NT; ++t) {
        TS(0);
        const int buf = t % NRING;
#define ATT_TILE_BARRIER() do { if (t + 1 < NT) { if (NVP == 4 && !ATT_LAG) { if (ATT_PF && t > 0) asm volatile("s_waitcnt vmcnt(7) lgkmcnt(0)" ::: "memory"); else asm volatile("s_waitcnt vmcnt(6) lgkmcnt(0)" ::: "memory"); }   \
            else asm volatile("s_waitcnt vmcnt(4) lgkmcnt(0)" ::: "memory"); } \
        else asm volatile("s_waitcnt vmcnt(0) lgkmcnt(0)" ::: "memory"); \
        __builtin_amdgcn_s_barrier(); asm volatile("" ::: "memory"); } while (0)
        if (!lagw && !MIDB) ATT_TILE_BARRIER();
        TS(1);
        TS(2);
#if ATT_EXP == 1
        if (!SWA && wid < 4) __builtin_amdgcn_s_sleep(6);
#elif ATT_EXP == 2
        if (!SWA && wid >= 4) __builtin_amdgcn_s_sleep(12);
#endif
        const int k0t = (u.j_lo + t) * KT;
        if (!SWA && !lagw && !MIDB) ATT_LDK(buf, 0);
#define ATT_TR(dst, ad, off) asm volatile("ds_read_b64_tr_b16 %0, %1 offset:%2" : "=&v"(dst) : "v"(ad), "i"(off) : "memory")
#pragma unroll
        for (int h = 0; h < 2; ++h) {
            const int k0 = k0t + 32 * h;
            const int nmin = qlo - (k0 + 31), nmax = qlo + 31 - k0;
            const bool active = (nmax >= 0) && (!SWA || nmin < 128);
            if (!SWA && ATT_FLIP && h == 1 && wid >= 4) __builtin_amdgcn_s_setprio(ATT_FLIP);
            if (active) {
                f32x16 p;
                if (SWA) ATT_LDK(buf, h);
                const bool farf = ATT_FASTFAR && !SWA && nmin >= 113 && have_ref;
#define ATT_QKCHAIN() do { _Pragma("unroll") for (int d = 1; d < 8; ++d) p = __builtin_amdgcn_mfma_f32_32x32x16_bf16(kf[d], qf[d], p, 0, 0, 0); } while (0)
                ATT_PRIO_UP();
                if (farf) p = __builtin_amdgcn_mfma_f32_32x32x16_bf16(kf[0], qf[0], negm, 0, 0, 0);
                else p = __builtin_amdgcn_mfma_f32_32x32x16_bf16(kf[0], qf[0], (f32x16){0.f, 0.f, 0.f, 0.f, 0.f, 0.f, 0.f, 0.f, 0.f, 0.f, 0.f, 0.f, 0.f, 0.f, 0.f, 0.f}, 0, 0, 0);
                ATT_QKCHAIN();
                ATT_PRIO_DN();
                __builtin_amdgcn_sched_barrier(0);
                if (!SWA && ATT_STAG && wslot == 3 * h + 0 && t + 2 < NT) { ATT_ISSUE(t + 2, (t + 2) % NRING); __builtin_amdgcn_sched_barrier(0); }
                if (h == 0 && lagw) ATT_TILE_BARRIER();
                const unsigned va = vaddr0 + (unsigned)(buf * V_BYTES);
#define ATT_TR4O(L0, H0, L1, H1, O_) do { \
                    if (h == 0) { ATT_TR(L0, a_, 0 * RS + O_); ATT_TR(H0, a_, 8 * RS + O_); ATT_TR(L1, a_, 16 * RS + O_); ATT_TR(H1, a_, 24 * RS + O_); } \
                    else        { ATT_TR(L0, a_, 32 * RS + O_); ATT_TR(H0, a_, 40 * RS + O_); ATT_TR(L1, a_, 48 * RS + O_); ATT_TR(H1, a_, 56 * RS + O_); } } while (0)
#define ATT_TR4(L0, H0, L1, H1, dd) do { const unsigned a_ = va ^ (unsigned)(((dd) & 3) << 6); \
                    if (((dd) >> 2) == 0) ATT_TR4O(L0, H0, L1, H1, 0); else ATT_TR4O(L0, H0, L1, H1, 256); } while (0)
                s16x4 al0, ah0, al1, ah1, bl0, bh0, bl1, bh1;
                ATT_TR4(al0, ah0, al1, ah1, 0);
                TS(3);
                float mn, alpha = 1.f, ps = 0.f; bool moved = false; bool classic = !farf;
                if (farf) {
#pragma unroll
                    for (int r = 0; r < 16; ++r) { p[r] = __builtin_amdgcn_exp2f(p[r]); ps += p[r]; }
                    if (!__all(ps <= 1.0e9f)) {
                        p = __builtin_amdgcn_mfma_f32_32x32x16_bf16(kf[0], qf[0], (f32x16){0.f, 0.f, 0.f, 0.f, 0.f, 0.f, 0.f, 0.f, 0.f, 0.f, 0.f, 0.f, 0.f, 0.f, 0.f, 0.f}, 0, 0, 0);
                        ATT_QKCHAIN(); ps = 0.f; classic = true; }
                }
                if (classic) {
                if (!SWA && nmin >= 113) { const float bfar = tb[127];
                    float pmax = p[0];
#pragma unroll
                    for (int r = 1; r < 16; ++r) pmax = fmaxf(pmax, p[r]);
                    pmax = fmaf(half_max(pmax), CQ, bfar);
                    mn = m_reg;
                    if (!__all(pmax - m_reg <= THR)) { mn = fmaxf(m_reg, pmax); alpha = __builtin_amdgcn_exp2f(m_reg - mn); m_reg = mn; moved = true; }
                    const float sh = bfar - mn;
#pragma unroll
                    for (int r = 0; r < 16; ++r) { p[r] = __builtin_amdgcn_exp2f(fmaf(p[r], CQ, sh)); ps += p[r]; }
#pragma unroll
                    for (int r = 0; r < 16; ++r) negm[r] = sh;
                    have_ref = true; }
                else { const int nb = qlo + c - k0 - 4 * hi; const unsigned W = SWA ? 128u : 0x7fffffffu; const float NEG = -__builtin_inff();
#pragma unroll
                    for (int r = 0; r < 16; ++r) { const int n0 = nb - ((r & 3) + 8 * (r >> 2));
                        const int i0 = n0 < 0 ? 0 : (n0 > 127 ? 127 : n0);
                        const float t0 = fmaf(p[r], CQ, tb[i0]);
                        p[r] = ((unsigned)n0 >= W) ? NEG : t0;
                        if ((r & 3) == 3) __builtin_amdgcn_sched_barrier(0); }
                    float pmax = p[0];
#pragma unroll
                    for (int r = 1; r < 16; ++r) pmax = fmaxf(pmax, p[r]);
                    pmax = half_max(pmax);
                    mn = m_reg;
                    if (!__all(pmax - m_reg <= THR)) { mn = fmaxf(m_reg, pmax); alpha = __builtin_amdgcn_exp2f(m_reg - mn); m_reg = mn; moved = true; }
#pragma unroll
                    for (int r = 0; r < 16; ++r) { p[r] = __builtin_amdgcn_exp2f(p[r] - mn); ps += p[r]; }
                    if (moved) have_ref = false; }
                }
                ps = half_sum(ps);
                l_reg = l_reg * alpha + ps;
                if (moved) { if (hi == 0) al_l[c] = alpha;     asm volatile("s_waitcnt lgkmcnt(0)" ::: "memory");
#pragma unroll
                    for (int r = 0; r < 16; ++r) { const float av = al_l[crow(r, hi)];
#pragma unroll
                        for (int d0 = 0; d0 < ND0; ++d0) o[d0][r] *= av; } }
                bf16x8 pa[2];
#pragma unroll
                for (int j = 0; j < 2; ++j) { const int b = 8 * j; u32x4 w;
                    w.x = cvtpk(p[b + 0], p[b + 1]); w.y = cvtpk(p[b + 2], p[b + 3]); w.z = cvtpk(p[b + 4], p[b + 5]); w.w = cvtpk(p[b + 6], p[b + 7]);
                    pa[j] = *reinterpret_cast<bf16x8*>(&w); }
                TS(4);
                if (!SWA && ATT_STAG && wslot == 3 * h + 1 && t + 2 < NT) { ATT_ISSUE(t + 2, (t + 2) % NRING); __builtin_amdgcn_sched_barrier(0); }
                if (h == 1 && (lagw || MIDB) && t + 1 < NT) ATT_LDK((t + 1) % NRING, 0);
                if (!SWA && !ATT_DMAPV && h == 0) ATT_LDK(buf, 1);
#define ATT_PV2(L0, H0, L1, H1, dd) do { \
                    o[dd] = __builtin_amdgcn_mfma_f32_32x32x16_bf16(pa[0], (bf16x8){L0[0], L0[1], L0[2], L0[3], H0[0], H0[1], H0[2], H0[3]}, o[dd], 0, 0, 0); \
                    o[dd] = __builtin_amdgcn_mfma_f32_32x32x16_bf16(pa[1], (bf16x8){L1[0], L1[1], L1[2], L1[3], H1[0], H1[1], H1[2], H1[3]}, o[dd], 0, 0, 0); } while (0)
                {
#pragma unroll
                    for (int d0 = 0; d0 < ND0; d0 += 2) {
                        const bool kq = !SWA && ATT_DMAPV && h == 0;
                        ATT_TR4(bl0, bh0, bl1, bh1, d0 + 1);
                        if (kq && d0 == 6) asm volatile("s_waitcnt lgkmcnt(12)" ::: "memory");
                        else asm volatile("s_waitcnt lgkmcnt(4)" ::: "memory");
                        __builtin_amdgcn_sched_barrier(0);
                        ATT_PRIO_UP(); ATT_PV2(al0, ah0, al1, ah1, d0); ATT_PRIO_DN();
                        __builtin_amdgcn_sched_barrier(0);
                        if (!SWA && ATT_DMAPV && d0 < 6 && t + 2 < NT) { ATT_PIECE(t + 2, (t + 2) % NRING, 3 * h + (d0 >> 1)); __builtin_amdgcn_sched_barrier(0); }
                        if (d0 + 2 < ND0) { ATT_TR4(al0, ah0, al1, ah1, d0 + 2);
                            if (kq && d0 == 4) { ATT_LDK(buf, 1); asm volatile("s_waitcnt lgkmcnt(12)" ::: "memory"); }
                            else asm volatile("s_waitcnt lgkmcnt(4)" ::: "memory"); }
                        else asm volatile("s_waitcnt lgkmcnt(0)" ::: "memory");
                        __builtin_amdgcn_sched_barrier(0);
                        ATT_PRIO_UP(); ATT_PV2(bl0, bh0, bl1, bh1, d0 + 1); ATT_PRIO_DN();
                        __builtin_amdgcn_sched_barrier(0);
                    }
                }
#undef ATT_TR4
#undef ATT_TR4O
#undef ATT_PV2
#undef ATT_QKCHAIN
                TS(5);
            }
            if (!active && h == 0 && lagw) ATT_TILE_BARRIER();
            if (MIDB && h == 0) { asm volatile("s_waitcnt vmcnt(0) lgkmcnt(0)" ::: "memory"); __builtin_amdgcn_s_barrier(); asm volatile("" ::: "memory"); }
            if (!SWA && ATT_FLIP && h == 1 && wid >= 4) __builtin_amdgcn_s_setprio(0);
            if (!SWA && ATT_STAG) { if ((wslot == 3 * h + 2 || (!active && wslot >= 3 * h && wslot < 3 * h + 2)) && t + 2 < NT) ATT_ISSUE(t + 2, (t + 2) % NRING); }
            else if (!SWA && ATT_BUFDMA) { if (t + 2 < NT) ATT_BISSUE(t + 2, (t + 2) % NRING, h); }
            else if ((SWA || !ATT_DMAPV || !active) && t + 2 < NT) ATT_ISSUE_HALF(t + 2, (t + 2) % NRING, h);
            if (!SWA && ATT_PF && h == 0 && t + 2 < NT) ATT_PREFETCH(t + 4);
        }
#undef ATT_TR
    }
#undef ATT_ISSUE
#undef ATT_LDK
#undef ATT_TILE_BARRIER
#if ATT_EXP == 4
    __builtin_amdgcn_s_setprio(0);
#endif
#undef ATT_ISSUE_K
#undef ATT_ISSUE_KR
#undef ATT_PIECE
#undef ATT_ISSUE_V
#undef ATT_ISSUE_HALF
#undef ATT_BISSUE
#undef ATT_RAWLD
#undef ATT_PREFETCH
#if MK_TMETRIC >= 0
    if (tmeas && tm_out != nullptr && lane == 0) { const unsigned tot = tacc[0] + tacc[1] + tacc[2] + tacc[3] + tacc[4] + tacc[5]; *tm_out = (float)(MK_TMETRIC < 6 ? tacc[MK_TMETRIC < 6 ? MK_TMETRIC : 0] : tot) / (float)NT; }
#endif
#undef TS
    { const int lane = fresh_lane(), c = lane & 31, hi = lane >> 5;
    if (hi == 0) li_l[c] = l_reg;
    asm volatile("s_waitcnt lgkmcnt(0)" ::: "memory");
    if (SWA) {
        const unsigned ob = (unsigned)((qlo + 4 * hi) * MIXP + c);
#pragma unroll
        for (int r = 0; r < 16; ++r) { const float rl = 1.0f / li_l[crow(r, hi)]; const unsigned ro = ob + (unsigned)(((r & 3) + 8 * (r >> 2)) * MIXP);
#pragma unroll
            for (int d0 = 0; d0 < ND0; ++d0) { const float v = o[d0][r] * rl; const float vn = swz_xor<1>(v);
                if ((c & 1) == 0) *(unsigned*)(OUT + hoff + ro + d0 * 32) = cvtpk(v, vn); } }
    } else if (comp == 0) {
        u32x4* slab = (u32x4*)T1 + ((size_t)(u.q0 >> 8) * 8 + wid) * 1024 + lane;
#pragma unroll
        for (int r = 0; r < 16; ++r) { const float rl = 1.0f / li_l[crow(r, hi)]; u32x4 w;
            w.x = cvtpk(o[0][r] * rl, o[1][r] * rl); w.y = cvtpk(o[2][r] * rl, o[3][r] * rl); w.z = cvtpk(o[4][r] * rl, o[5][r] * rl); w.w = cvtpk(o[6][r] * rl, o[7][r] * rl);
            slab[r * 64] = w; }
    } else {
        const unsigned ob = (unsigned)((qlo + 4 * hi) * MIXP + c);
        float gsc[ND0];
#pragma unroll
        for (int d0 = 0; d0 < ND0; ++d0) gsc[d0] = subg[d0 * 32 + c];
        const u32x4* slab = (const u32x4*)T1 + ((size_t)(u.q0 >> 8) * 8 + wid) * 1024 + lane;
#pragma unroll
        for (int rb = 0; rb < 16; rb += 4) {
            u32x4 tw[4];
#pragma unroll
            for (int rr = 0; rr < 4; ++rr) tw[rr] = slab[(rb + rr) * 64];
            asm volatile("" ::: "memory");
#pragma unroll
            for (int rr = 0; rr < 4; ++rr) { const int r = rb + rr; const float rl = lam / li_l[crow(r, hi)]; float ss = 0.f;
                float y[ND0];
#pragma unroll
                for (int d0 = 0; d0 < ND0; d0 += 2) { const unsigned w = tw[rr][d0 >> 1];
                    y[d0] = __builtin_bit_cast(float, w << 16) - o[d0][r] * rl; y[d0 + 1] = __builtin_bit_cast(float, w & 0xffff0000u) - o[d0 + 1][r] * rl; ss += y[d0] * y[d0] + y[d0 + 1] * y[d0 + 1]; }
                ss += swz_xor<1>(ss); ss += swz_xor<2>(ss); ss += swz_xor<4>(ss); ss += swz_xor<8>(ss); ss += swz_xor<16>(ss);
                const float rs = oscale / sqrtf(ss * (1.0f / 256.0f) + 1e-6f);
                const unsigned oo = ob + (unsigned)(((r & 3) + 8 * (r >> 2)) * MIXP);
#pragma unroll
                for (int d0 = 0; d0 < ND0; ++d0) { const float v = y[d0] * rs * gsc[d0]; const float vn = swz_xor<1>(v);
                    if ((c & 1) == 0) *(unsigned*)(OUT + oo + d0 * 32) = cvtpk(v, vn); } }
            asm volatile("" ::: "memory");
        }
    } }
    asm volatile("s_waitcnt lgkmcnt(0)" ::: "memory"); __builtin_amdgcn_s_barrier(); asm volatile("" ::: "memory");
}
}


constexpr int NWAVES = 8;
constexpr int SEQ = 16384, DM = 4096, DEPTH = 2, IN_COLS = 8704, MIXW = 4096, DFF = 11008, UPC = 2 * DFF, NMODC = 6 * DM;
constexpr int QA_OFF = 0, KA_OFF = 2048, VA_OFF = 2304, QB_OFF = 2560, KB_OFF = 4608, VB_OFF = 6656;
constexpr float EPS = 1e-6f;
constexpr size_t MiB = 1u << 20;
constexpr size_t WS_CTL = 0, CTL_ZERO_BYTES = 1 * MiB;
constexpr size_t WS_PART = 1 * MiB;
constexpr size_t WS_MOD = 3 * MiB;
constexpr size_t WS_WIN = 4 * MiB;
constexpr size_t WS_WOUT = 140 * MiB;
constexpr size_t WS_WUP = 204 * MiB;
constexpr size_t WS_WDOWN = 548 * MiB;
constexpr size_t WS_H = 720 * MiB;
constexpr size_t WS_PROJ = 848 * MiB;
constexpr size_t WS_MIX = 1120 * MiB;
constexpr size_t WS_T1 = 1248 * MiB;
constexpr size_t WS_U = 1376 * MiB;
constexpr size_t WS_ACT = 2064 * MiB;
constexpr size_t WS_END = 2408 * MiB;
constexpr int CW_BAR = 4096;
constexpr int RING_BYTES = 131072, LDSCTL_OFF = 151552, LDS_BYTES = 155648;
static_assert(att::ATT_LDS <= LDSCTL_OFF, "attention LDS map");

typedef unsigned short bf16;
typedef unsigned v4u __attribute__((ext_vector_type(4)));
typedef unsigned v2u __attribute__((ext_vector_type(2)));
typedef float f32x4 __attribute__((ext_vector_type(4)));
#define LDS_WAIT() asm volatile("s_waitcnt lgkmcnt(0)" ::: "memory")
#define VM_WAIT() asm volatile("s_waitcnt vmcnt(0)" ::: "memory")
__device__ __forceinline__ unsigned f2bf(float f) { unsigned u = __builtin_bit_cast(unsigned, f); return (u + 0x7fffu + ((u >> 16) & 1u)) >> 16; }
__device__ __forceinline__ unsigned pk2(float lo, float hi) { return f2bf(lo) | (f2bf(hi) << 16); }
__device__ __forceinline__ float bf2f(unsigned short b) { return __builtin_bit_cast(float, (unsigned)b << 16); }

__device__ __forceinline__ void transpose_item(const float* W, int K, int N, bf16* WT, LAS float* scr, int item, int lane, int gu = 0, int sc_lo = 0, int sc_hi = 0, float sc = 1.0f, int blk = 0) {
    const int nblk = N / 32, kb = item / nblk, nb = item % nblk, k0 = 64 * kb, n0 = 32 * nb;
    int r0 = n0; if (gu) { const int mm = n0 < gu ? n0 : n0 - gu; r0 = (mm >> 7) * 256 + (n0 < gu ? 0 : 128) + (mm & 127); }
    float tmp[32];
#pragma unroll
    for (int i = 0; i < 32; ++i) { const int kk = 2 * i + (lane >> 5); tmp[i] = W[(size_t)(k0 + kk) * N + n0 + (lane & 31)]; }
    const float scl = (n0 >= sc_lo && n0 < sc_hi) ? sc : 1.0f;
#pragma unroll
    for (int i = 0; i < 32; ++i) { const int kk = 2 * i + (lane >> 5); scr[kk * 33 + (lane & 31)] = tmp[i] * scl; }
    LDS_WAIT(); asm volatile("" ::: "memory");
    const int c = lane & 7;
#pragma unroll
    for (int j = 0; j < 4; ++j) { const int n = (lane >> 3) + 8 * j; const LAS float* s = scr + (8 * c) * 33 + n;
        v4u o; o.x = pk2(s[0 * 33], s[1 * 33]); o.y = pk2(s[2 * 33], s[3 * 33]); o.z = pk2(s[4 * 33], s[5 * 33]); o.w = pk2(s[6 * 33], s[7 * 33]);
        *(v4u*)(WT + (blk ? ((size_t)(k0 >> 6) * N + (r0 + n)) * 64 : (size_t)(r0 + n) * K + k0) + 8 * c) = o; }
    LDS_WAIT(); asm volatile("" ::: "memory");
}

struct Args {
    const float* in[20]; float* out; unsigned char* ws; int ph_lo, ph_hi, li, pad;
};
enum { I_X = 0, I_C, I_ADAW, I_ADAB, I_ANG, I_MNG, I_WIN, I_SINK, I_LQ1, I_LK1, I_LQ2, I_LK2, I_SUBG, I_WOUT, I_RELB, I_WUP, I_CONVW, I_CONVB, I_WDOWN, I_FING };

constexpr int N_PHASES = 19;

__device__ __forceinline__ void norm_mod_phase(LAS unsigned char* lds, const float* xin, const float* g, const float* shift, const float* scale, bf16* hout, int vcu, int G, const int wave) {
    const int lane = fresh_lane(), tid = wave * 64 + lane;
    LAS float* A = (LAS float*)lds; LAS float* B = A + DM;
    for (int j = tid; j < DM; j += NWAVES * 64) { A[j] = g[j] * (1.0f + scale[j]); B[j] = shift[j]; }
    __syncthreads();
    const int gw = vcu * NWAVES + wave, NGW = G * NWAVES;
    for (int row = gw; row < SEQ; row += NGW) {
        const f32x4* xr = (const f32x4*)(xin + (size_t)row * DM) + lane;
        f32x4 v[16]; float ss = 0.f;
#pragma unroll
        for (int i = 0; i < 16; ++i) { v[i] = xr[64 * i]; ss += (v[i].x * v[i].x + v[i].y * v[i].y) + (v[i].z * v[i].z + v[i].w * v[i].w); }
        const float rs = 1.0f / sqrtf(wave_sum(ss) * (1.0f / DM) + EPS);
        v2u* o8 = (v2u*)(hout + (size_t)row * DM) + lane;
#pragma unroll
        for (int i = 0; i < 16; ++i) { const f32x4 a = *(const LAS f32x4*)(A + 256 * i + 4 * lane), b = *(const LAS f32x4*)(B + 256 * i + 4 * lane);
            const f32x4 y = v[i] * rs * a + b; v2u w; w.x = pk2(y.x, y.y); w.y = pk2(y.z, y.w); o8[64 * i] = w; }
    }
    __syncthreads();
}

__global__ void __launch_bounds__(NWAVES * 64, 2) mega_fwd(Args args) {
    extern __shared__ __attribute__((aligned(16))) unsigned char lds_raw[];
    LAS unsigned char* lds = (LAS unsigned char*)lds_raw;
    const int wave = __builtin_amdgcn_readfirstlane((int)threadIdx.x >> 6);
    const int G = gridDim.x; const int bx = blockIdx.x;
    const int vcu = (G % 8 == 0) ? (bx % 8) * (G / 8) + bx / 8 : bx;
    unsigned char* ws = args.ws;
    unsigned* ctl = (unsigned*)(ws + WS_CTL);
    for (int u = threadIdx.x; u < (LDS_BYTES - LDSCTL_OFF) / 4; u += NWAVES * 64) ((LAS unsigned*)(lds + LDSCTL_OFF))[u] = 0u;
    __syncthreads();
    XcdBarrier bar = xcd_barrier_post(ctl + CW_BAR + (MK_PER_PHASE ? 0 : args.li) * XCD_BAR_WORDS, (volatile LAS unsigned*)(lds + LDSCTL_OFF + 64));
#if MK_PER_PHASE
    const int lo = args.ph_lo, hi = args.ph_hi;
#else
    constexpr int lo = 0, hi = N_PHASES;
#endif
#define IN(k) (lo <= (k) && (k) < hi)
#define SEAM(k) do { if (IN(k) && IN((k) + 1)) { XcdBarrier bl_ = bar; unsigned long long bp_ = (unsigned long long)bar.bar; asm volatile("" : "+s"(bp_), "+s"(bl_.x)); bl_.bar = (unsigned*)(__attribute__((address_space(1))) unsigned*)bp_;     \
        xcd_barrier(bl_); if (MK_DUP & 0x800) xcd_barrier(bl_); } } while (0)

    float* const xres = args.out;
    float* const part = (float*)(ws + WS_PART); float* const mod = (float*)(ws + WS_MOD);
    bf16* const Hb = (bf16*)(ws + WS_H); bf16* const PROJ = (bf16*)(ws + WS_PROJ); bf16* const MIXB = (bf16*)(ws + WS_MIX);
    float* const T1 = (float*)(ws + WS_T1); bf16* const Ub = (bf16*)(ws + WS_U); bf16* const ACT = (bf16*)(ws + WS_ACT);
    float* const HALO = (float*)(ws + WS_U + 512 * MiB); float* const FIXC = HALO + (size_t)64 * 2 * DFF; float* const FIXU = FIXC + (size_t)64 * 2 * DFF;
    const int gw = vcu * NWAVES + wave, NGW = G * NWAVES;
    constexpr int I_IN = (DM / 64) * (IN_COLS / 32), I_OUT = (MIXW / 64) * (DM / 32), I_UP = (DM / 64) * (UPC / 32), I_DN = (DFF / 64) * (DM / 32), I_L = I_IN + I_OUT + I_UP + I_DN;
    const bool defer = MK_DEFER && !MK_PER_PHASE && G == 256;

#ifndef NO_PRO
    if (IN(0)) for (int rep = 0; rep < 1 + ((MK_DUP >> 8) & 1); ++rep) {
        const int lane = fresh_lane(), tid = wave * 64 + lane;
        LAS float* cs = (LAS float*)(lds + 69632);
        for (int j = tid; j < DM; j += NWAVES * 64) { const float cv = args.in[I_C][j]; cs[j] = cv / (1.0f + __expf(-cv)); }
        __syncthreads();
        for (int it = gw; it < 2 * 96 * 8; it += NGW) {
            const int kc = it & 7, cb = (it >> 3) % 96, l = it / (8 * 96);
            const float* W = args.in[I_ADAW] + ((size_t)l * DM + (size_t)kc * 512) * NMODC + cb * 256 + lane * 4;
            f32x4 acc = (f32x4){0.f, 0.f, 0.f, 0.f};
            for (int k = 0; k < 512; k += 16) {
                f32x4 w[16];
#pragma unroll
                for (int i = 0; i < 16; ++i) w[i] = *(const f32x4*)(W + (size_t)(k + i) * NMODC);
#pragma unroll
                for (int i = 0; i < 16; ++i) acc += w[i] * cs[kc * 512 + k + i];
            }
            *(f32x4*)(part + ((size_t)kc * 2 + l) * NMODC + cb * 256 + lane * 4) = acc;
        }
        LAS float* scr = (LAS float*)(lds + wave * 8448);
        for (int it = gw; it < (defer ? I_IN : 2 * I_L); it += NGW) {
            const int l = it / I_L; int r = it % I_L;
            if (r < I_IN) { transpose_item(args.in[I_WIN] + (size_t)l * DM * IN_COLS, DM, IN_COLS, (bf16*)(ws + WS_WIN) + (size_t)l * IN_COLS * DM, scr, r, lane, 0, QB_OFF, KB_OFF, att::C2, MK_BLKB); continue; } r -= I_IN;
            if (r < I_OUT) { transpose_item(args.in[I_WOUT] + (size_t)l * MIXW * DM, MIXW, DM, (bf16*)(ws + WS_WOUT) + (size_t)l * DM * MIXW, scr, r, lane, 0, 0, 0, 1.0f, MK_BLKB); continue; } r -= I_OUT;
            if (r < I_UP) { transpose_item(args.in[I_WUP] + (size_t)l * DM * UPC, DM, UPC, (bf16*)(ws + WS_WUP) + (size_t)l * UPC * DM, scr, r, lane, DFF, 0, 0, 1.0f, MK_BLKB); continue; } r -= I_UP;
            transpose_item(args.in[I_WDOWN] + (size_t)l * DFF * DM, DFF, DM, (bf16*)(ws + WS_WDOWN) + (size_t)l * DM * DFF, scr, r, lane, 0, 0, 0, 1.0f, MK_BLKB);
        }
        __syncthreads();
    }
#endif
    SEAM(0);
    if (IN(1)) {
        for (int j = bx * (NWAVES * 64) + wave * 64 + fresh_lane(); j < 2 * NMODC; j += G * NWAVES * 64) {
            float s = args.in[I_ADAB][j];
#pragma unroll
            for (int p = 0; p < 8; ++p) s += part[(size_t)p * 2 * NMODC + j];
            mod[j] = s;
        }
    }
    SEAM(1);

    for (int l = 0; l < DEPTH; ++l) {
        const int pb = 2 + 8 * l;
        const float* modl = mod + (size_t)l * NMODC;
        if (IN(pb + 0)) for (int rep = 0; rep < 1 + ((MK_DUP >> 0) & 1); ++rep) norm_mod_phase(lds, l == 0 ? args.in[I_X] : xres, args.in[I_ANG] + l * DM, modl + 0 * DM, modl + 1 * DM, Hb, vcu, G, wave);
        SEAM(pb + 0);
#if !defined(NO_GEMM) && !defined(NO_G1)
        if (IN(pb + 1)) {
            pg8::Gemm g{Hb, (const bf16*)(ws + WS_WIN) + (size_t)l * IN_COLS * DM, SEQ, IN_COLS, DM, MK_BLKB}; pg8::StaticOrder S; S.init(SEQ, IN_COLS, G, bx);
            pg8::EpiBf16 E{PROJ, IN_COLS};
            const bool tail = MK_HALFTAIL && !MK_BLKB && G == 256 && (S.nwg % G) * 2 == G;
            if (tail) S.lim = S.nwg - S.nwg % G;
            for (int rep = 0; rep < 1 + ((MK_DUP >> 1) & 1); ++rep) pg8::gemm_phase<pg8::EpiBf16, pg8::StaticOrder, true, true>(lds, g, S, E, wave);
            if (tail) { pg8::Unit ut; S.map(S.lim + (bx & 127), ut); pg8::gemm_half_unit<pg8::EpiBf16>(lds, g, ut, bx >> 7, E, wave); }
        }
#endif
        SEAM(pb + 1);
        if (IN(pb + 2)) {
            const float lam_init = l == 0 ? 0.2f : 0.35550906759096927f, oscale = __builtin_bit_cast(float, __builtin_amdgcn_readfirstlane(l == 0 ? 0x3f4ccccd : 0x3f24fd5c));
            float lam;
            { const int lane = fresh_lane();
              const float* q1 = args.in[I_LQ1] + l * 128; const float* k1 = args.in[I_LK1] + l * 128; const float* q2 = args.in[I_LQ2] + l * 128; const float* k2 = args.in[I_LK2] + l * 128;
              const float s1 = wave_sum(q1[lane] * k1[lane] + q1[lane + 64] * k1[lane + 64]), s2 = wave_sum(q2[lane] * k2[lane] + q2[lane + 64] * k2[lane + 64]);
              lam = __builtin_bit_cast(float, __builtin_amdgcn_readfirstlane(__builtin_bit_cast(int, expf(s1) - expf(s2) + lam_init))); }
            const float* relb = args.in[I_RELB];
            for (int rep = 0; rep < 1 + ((MK_DUP >> 2) & 1); ++rep) {
#ifndef NO_SWA
            for (int rep2 = 0; rep2 < 1 + ((MK_DUP >> 9) & 1); ++rep2)
            for (int uu = vcu; uu < 1024; uu += G) {
                const int kvh = uu >> 9, qb = uu & 511, q0 = qb * 32;
                att::UnitDesc ud; ud.Q = PROJ + QA_OFF + kvh * 8 * 128; ud.K = PROJ + KA_OFF + kvh * 128; ud.V = PROJ + VA_OFF + kvh * 128;
                ud.q0 = q0; ud.j_lo = q0 < 127 ? 0 : (q0 - 127) >> 6; ud.NT = ((q0 + 31) >> 6) + 1 - ud.j_lo;
                ud.m_init = 0.f; ud.l_init = 1.0f; ud.bias = relb; ud.bias_col = kvh * 8; ud.sinks = args.in[I_SINK] + l * 16 + kvh * 8;
                att::attn_unit<true>(lds, ud, 0, nullptr, MIXB + kvh * 8 * 128, 0.f, nullptr, 0.f, wave);
            }
#endif
#ifndef NO_DIFF
            for (int rep3 = 0; rep3 < 1 + ((MK_DUP >> 10) & 1); ++rep3)
            for (int pp = vcu; pp < 256; pp += G) {
                const int h = pp >> 5, pi = pp & 31;
                for (int s = 0; s < 4; ++s) {
                    if (defer && l == 0 && s == ((vcu >> 5) & 3)) {
                        __syncthreads();
                        const int lane_ = fresh_lane(); LAS float* scr = (LAS float*)(lds + wave * 8448);
                        for (int d = gw; d < 2 * I_L - I_IN; d += NGW) {
                            const int l2 = d < I_L - I_IN ? 0 : 1; int r = l2 == 0 ? d + I_IN : d - (I_L - I_IN);
                            if (r < I_IN) { transpose_item(args.in[I_WIN] + (size_t)l2 * DM * IN_COLS, DM, IN_COLS, (bf16*)(ws + WS_WIN) + (size_t)l2 * IN_COLS * DM, scr, r, lane_, 0, QB_OFF, KB_OFF, att::C2, MK_BLKB); continue; } r -= I_IN;
                            if (r < I_OUT) { transpose_item(args.in[I_WOUT] + (size_t)l2 * MIXW * DM, MIXW, DM, (bf16*)(ws + WS_WOUT) + (size_t)l2 * DM * MIXW, scr, r, lane_, 0, 0, 0, 1.0f, MK_BLKB); continue; } r -= I_OUT;
                            if (r < I_UP) { transpose_item(args.in[I_WUP] + (size_t)l2 * DM * UPC, DM, UPC, (bf16*)(ws + WS_WUP) + (size_t)l2 * UPC * DM, scr, r, lane_, DFF, 0, 0, 1.0f, MK_BLKB); continue; } r -= I_UP;
                            transpose_item(args.in[I_WDOWN] + (size_t)l2 * DFF * DM, DFF, DM, (bf16*)(ws + WS_WDOWN) + (size_t)l2 * DM * DFF, scr, r, lane_, 0, 0, 0, 1.0f, MK_BLKB);
                        }
                        __syncthreads();
                    }
                    const int qb = (s & 1) ? pi : 63 - pi, comp = s >> 1;
                    att::UnitDesc ud; ud.Q = PROJ + QB_OFF + h * 256 + comp * 128; ud.K = PROJ + KB_OFF + h * 256 + comp * 128; ud.V = PROJ + VB_OFF + h * 256;
                    ud.q0 = qb * 256; ud.j_lo = 0; ud.NT = 4 * qb + 4; ud.m_init = -1e30f; ud.l_init = 0.f; ud.bias = relb; ud.bias_col = 16 + h; ud.sinks = nullptr;
                    att::attn_unit<false>(lds, ud, comp, T1 + (size_t)h * (64 * 8 * 1024 * 4), MIXB + 2048 + h * 256, lam, args.in[I_SUBG] + l * 256, oscale, wave, (MK_TMETRIC >= 0 && bx == 0 && l == 0) ? (float*)(ws + WS_CTL) + 32 : nullptr);
                }
            }
#endif
            }
        }
        SEAM(pb + 2);
#if !defined(NO_GEMM) && !defined(NO_G3)
        if (IN(pb + 3)) {
            pg8::Gemm g{MIXB, (const bf16*)(ws + WS_WOUT) + (size_t)l * DM * MIXW, SEQ, DM, MIXW, MK_BLKB}; pg8::StaticOrder S; S.init(SEQ, DM, G, bx, MK_WGM_OUT);
            if ((MK_DUP >> 3) & 1) { pg8::EpiResGate Ed{l == 0 ? args.in[I_X] : xres, (float*)Ub, DM, modl + 2 * DM}; pg8::gemm_phase<pg8::EpiResGate, pg8::StaticOrder, false, true>(lds, g, S, Ed, wave); }
            if (MK_SKEW > 0) {
                const unsigned long long t0_ = wall_clock64(); const unsigned dl_ = ((unsigned)vcu * (unsigned)MK_SKEW) >> 8;
                while ((unsigned)(wall_clock64() - t0_) < dl_) __builtin_amdgcn_s_sleep(8); }
            pg8::EpiResGate E{l == 0 ? args.in[I_X] : xres, xres, DM, modl + 2 * DM};
            pg8::gemm_phase<pg8::EpiResGate, pg8::StaticOrder, false, true>(lds, g, S, E, wave);
        }
#endif
        SEAM(pb + 3);
        if (IN(pb + 4)) for (int rep = 0; rep < 1 + ((MK_DUP >> 4) & 1); ++rep) norm_mod_phase(lds, xres, args.in[I_MNG] + l * DM, modl + 3 * DM, modl + 4 * DM, Hb, vcu, G, wave);
        SEAM(pb + 4);
#if !defined(NO_GEMM) && !defined(NO_G5)
        if (IN(pb + 5)) {
            pg8::Gemm g{Hb, (const bf16*)(ws + WS_WUP) + (size_t)l * UPC * DM, SEQ, UPC, DM, MK_BLKB}; pg8::StaticOrder S; S.init(SEQ, UPC, G, bx);
            pg8::EpiConvGate E{ACT, DFF, args.in[I_CONVW] + (size_t)l * 3 * DFF, args.in[I_CONVB] + (size_t)l * DFF, HALO, FIXC, FIXU, (PG8_LAS pg8::f32x4*)(lds + RING_BYTES)};
            for (int rep = 0; rep < 1 + ((MK_DUP >> 5) & 1); ++rep) pg8::gemm_phase<pg8::EpiConvGate, pg8::StaticOrder, true, true>(lds, g, S, E, wave);
        }
#endif
        SEAM(pb + 5);
#ifndef NO_CONV
        if (IN(pb + 6)) {
            const float* cw = args.in[I_CONVW] + (size_t)l * 3 * DFF;
            const int tl_ = wave * 64 + fresh_lane();
            for (int i = bx * (NWAVES * 64) + tl_; i < 63 * 2 * DFF; i += G * NWAVES * 64) {
                const int f = i % DFF, rr = (i / DFF) & 1, pm = 1 + i / (2 * DFF);
                const float h254 = HALO[((size_t)(pm - 1) * 2 + 0) * DFF + f], h255 = HALO[((size_t)(pm - 1) * 2 + 1) * DFF + f];
                float cv = FIXC[((size_t)pm * 2 + rr) * DFF + f];
                cv += rr == 0 ? cw[f] * h254 + cw[DFF + f] * h255 : cw[f] * h255;
                const float o = cv / (1.0f + __expf(-cv)) * FIXU[((size_t)pm * 2 + rr) * DFF + f];
                ACT[MK_BLKA ? ((size_t)(f >> 6) * SEQ + (pm * 256 + rr)) * 64 + (f & 63) : (size_t)(pm * 256 + rr) * DFF + f] = (bf16)f2bf(o);
            }
        }
#endif
        SEAM(pb + 6);
#if !defined(NO_GEMM) && !defined(NO_G7)
        if (IN(pb + 7)) {
            pg8::Gemm g{ACT, (const bf16*)(ws + WS_WDOWN) + (size_t)l * DM * DFF, SEQ, DM, DFF, MK_BLKB, MK_BLKA}; pg8::StaticOrder S; S.init(SEQ, DM, G, bx, MK_WGM_DOWN);
#if defined(MK_DUPE)
            if ((MK_DUP >> 7) & 1) { pg8::EpiBf16 Ed{Ub, DM}; pg8::gemm_phase<pg8::EpiBf16, pg8::StaticOrder, false, true>(lds, g, S, Ed, wave); }
#else
            if ((MK_DUP >> 7) & 1) { pg8::EpiResGate Ed{xres, (float*)Ub, DM, modl + 5 * DM}; pg8::gemm_phase<pg8::EpiResGate, pg8::StaticOrder, false, true>(lds, g, S, Ed, wave); }
#endif
            if (MK_SKEW > 0) {
                const unsigned long long t0_ = wall_clock64(); const unsigned dl_ = ((unsigned)vcu * (unsigned)MK_SKEW) >> 8;
                while ((unsigned)(wall_clock64() - t0_) < dl_) __builtin_amdgcn_s_sleep(8); }
            pg8::EpiResGate E{xres, xres, DM, modl + 5 * DM};
            pg8::gemm_phase<pg8::EpiResGate, pg8::StaticOrder, false, true>(lds, g, S, E, wave);
        }
#endif
        SEAM(pb + 7);
    }
    if (IN(18)) {
        const float* fg = args.in[I_FING];
        const int lane = fresh_lane();
        for (int row = gw; row < SEQ; row += NGW) {
            f32x4* xr = (f32x4*)(xres + (size_t)row * DM) + lane;
            f32x4 v[16]; float ss = 0.f;
#pragma unroll
            for (int i = 0; i < 16; ++i) { v[i] = xr[64 * i]; ss += (v[i].x * v[i].x + v[i].y * v[i].y) + (v[i].z * v[i].z + v[i].w * v[i].w); }
            const float rs = 1.0f / sqrtf(wave_sum(ss) * (1.0f / DM) + EPS);
#pragma unroll
            for (int i = 0; i < 16; ++i) { const f32x4 gq = *((const f32x4*)fg + 64 * i + lane); xr[64 * i] = v[i] * rs * gq; }
        }
    }
#if MK_TMETRIC >= 0
    if (bx == 0 && wave == 0 && fresh_lane() == 0) { asm volatile("s_waitcnt vmcnt(0)" ::: "memory"); xres[5] = 1000.0f * (250.0f * floorf(((const float*)(ws + WS_CTL))[32] / 250.0f + 0.5f)); }
#endif
#undef IN
#undef SEAM
}


#if MK_PROBE
__device__ __forceinline__ int probe_row(int i) { const int fixed[24] = {0, 1, 2, 3, 31, 32, 33, 63, 64, 65, 127, 128, 129, 130, 255, 256, 257, 258, 4095, 4096, 8191, 8192, 16382, 16383};
    return i < 24 ? fixed[i] : (int)(((unsigned)i * 2654435761u) >> 18) & 16383; }
__device__ __forceinline__ float pbf(const bf16* p, size_t i) { return bf2f(p[i]); }
__device__ __forceinline__ void probe_fail(unsigned* flags, int bit, float got, float ref, float tol) { if (!(fabsf(got - ref) <= tol)) atomicOr(flags, 1u << bit); }
__global__ void probe_mod(const float* c, const float* adaw, const float* adab, const float* mod, unsigned* flags, int bit) {
    const int i = blockIdx.x * blockDim.x + threadIdx.x; if (i >= 2 * 512) return;
    const int l = i / 512, n = (int)(((unsigned)(i % 512) * 48u + (i % 7)) % NMODC);
    double s = adab[l * NMODC + n];
    for (int k = 0; k < DM; ++k) { const float cv = c[k]; s += (double)(cv / (1.0f + expf(-cv))) * (double)adaw[((size_t)l * DM + k) * NMODC + n]; }
    probe_fail(flags, bit, mod[l * NMODC + n], (float)s, 2e-3f + 2e-3f * fabsf((float)s));
}
__global__ void probe_norm(const float* xin, const float* g, const float* shift, const float* scale, const bf16* H, unsigned* flags, int bit) {
    __shared__ float red[256];
    const int row = probe_row(blockIdx.x); float ss = 0.f;
    for (int j = threadIdx.x; j < DM; j += 256) { const float v = xin[(size_t)row * DM + j]; ss += v * v; }
    red[threadIdx.x] = ss; __syncthreads();
    for (int o = 128; o > 0; o >>= 1) { if ((int)threadIdx.x < o) red[threadIdx.x] += red[threadIdx.x + o]; __syncthreads(); }
    const float rs = 1.0f / sqrtf(red[0] / DM + EPS);
    for (int j = threadIdx.x; j < DM; j += 256) { const float ref = xin[(size_t)row * DM + j] * rs * g[j] * (1.0f + scale[j]) + shift[j];
        probe_fail(flags, bit, pbf(H, (size_t)row * DM + j), ref, 0.01f + 0.01f * fabsf(ref)); }
}
__global__ void probe_gemm_bf16(const bf16* A, const float* W, const bf16* C, int K, int N, unsigned* flags, int bit) {
    const int row = probe_row(blockIdx.x);
    for (int s = threadIdx.x; s < 96; s += blockDim.x) {
        int col; if (s < 32) { const int edge[8] = {0, 1, 127, 128, 255, 256, N - 129, N - 1}; col = s < 8 ? edge[s] : (int)(((unsigned)(s + 97 * blockIdx.x) * 2654435761u) >> 8) % N; } else col = (int)(((unsigned)(s * 7919 + 31 * blockIdx.x) * 2246822519u) >> 8) % N;
        double acc = 0.0; for (int k = 0; k < K; ++k) acc += (double)pbf(A, (size_t)row * K + k) * (double)W[(size_t)k * N + col];
        probe_fail(flags, bit, pbf(C, (size_t)row * N + col), (float)acc, 0.03f + 0.02f * fabsf((float)acc)); }
}
__global__ void probe_gemm_res(const bf16* A, const float* W, const float* base, const float* gate, const float* out, int K, int N, unsigned* flags, int bit) {
    const int row = probe_row(blockIdx.x);
    for (int s = threadIdx.x; s < 96; s += blockDim.x) {
        int col; if (s < 8) { const int edge[8] = {0, 1, 127, 128, 255, 256, N - 129, N - 1}; col = edge[s]; } else col = (int)(((unsigned)(s * 7919 + 31 * blockIdx.x) * 2246822519u) >> 8) % N;
        double acc = 0.0; for (int k = 0; k < K; ++k) acc += (double)pbf(A, (size_t)row * K + k) * (double)W[(size_t)k * N + col];
        const float ref = base[(size_t)row * N + col] + gate[col] * (float)acc;
        probe_fail(flags, bit, out[(size_t)row * N + col], ref, 0.02f + 0.01f * fabsf(ref)); }
}
__global__ void probe_swa(const bf16* PROJ, const float* relb, const float* sinks, const bf16* MIXB, unsigned* flags, int bit) {
    __shared__ float q[128], pr[128], red[128];
    const int row = probe_row(blockIdx.x >> 4), h = blockIdx.x & 15, kvh = h >> 3, t = threadIdx.x;
    q[t] = pbf(PROJ, (size_t)row * IN_COLS + QA_OFF + h * 128 + t); __syncthreads();
    const int key = row - t; float lg = -1e30f;
    if (key >= 0) { float s = 0.f; for (int d = 0; d < 128; ++d) s += q[d] * pbf(PROJ, (size_t)key * IN_COLS + KA_OFF + kvh * 128 + d);
        lg = s * 0.08838834764831845f + relb[att::t5_bucket(t) * 24 + h]; }
    red[t] = lg; __syncthreads();
    for (int o = 64; o > 0; o >>= 1) { if (t < o) red[t] = fmaxf(red[t], red[t + o]); __syncthreads(); }
    const float mx = fmaxf(red[0], sinks[h]); __syncthreads();
    const float e = key >= 0 ? expf(lg - mx) : 0.f; pr[t] = e; red[t] = e; __syncthreads();
    for (int o = 64; o > 0; o >>= 1) { if (t < o) red[t] += red[t + o]; __syncthreads(); }
    const float den = red[0] + expf(sinks[h] - mx);
    float acc = 0.f; for (int j = 0; j < 128; ++j) { const int kk = row - j; if (kk >= 0) acc += pr[j] * pbf(PROJ, (size_t)kk * IN_COLS + VA_OFF + kvh * 128 + t); }
    const float ref = acc / den;
    probe_fail(flags, bit, pbf(MIXB, (size_t)row * MIXW + h * 128 + t), ref, 0.01f + 0.03f * fabsf(ref));
}
__global__ void probe_diff(const bf16* PROJ, const float* relb, const float* lq1, const float* lk1, const float* lq2, const float* lk2, const float* subg, float lam_init, const bf16* MIXB, float* scr_all, unsigned* flags, int bit) {
    __shared__ float q[256], red[256], red2[256];
    const int row = probe_row(blockIdx.x >> 3), h = blockIdx.x & 7, t = threadIdx.x; float* scr = scr_all + (size_t)blockIdx.x * 32768;
    q[t] = pbf(PROJ, (size_t)row * IN_COLS + QB_OFF + h * 256 + t); __syncthreads();
    float d1 = 0.f, d2 = 0.f; for (int i = 0; i < 128; ++i) { d1 += lq1[i] * lk1[i]; d2 += lq2[i] * lk2[i]; }
    const float lam = expf(d1) - expf(d2) + lam_init;
    float m1 = -1e30f, m2 = -1e30f;
    for (int k = t; k <= row; k += 256) { float s1 = 0.f, s2 = 0.f; const size_t kb = (size_t)k * IN_COLS + KB_OFF + h * 256;
        for (int d = 0; d < 128; ++d) { s1 += q[d] * pbf(PROJ, kb + d); s2 += q[128 + d] * pbf(PROJ, kb + 128 + d); }
        const int n = row - k; const float b = relb[att::t5_bucket(n > 127 ? 127 : n) * 24 + 16 + h];
        s1 = s1 * 0.08838834764831845f + b; s2 = s2 * 0.08838834764831845f + b; scr[k] = s1; scr[16384 + k] = s2; m1 = fmaxf(m1, s1); m2 = fmaxf(m2, s2); }
    red[t] = m1; red2[t] = m2; __syncthreads();
    for (int o = 128; o > 0; o >>= 1) { if (t < o) { red[t] = fmaxf(red[t], red[t + o]); red2[t] = fmaxf(red2[t], red2[t + o]); } __syncthreads(); }
    m1 = red[0]; m2 = red2[0]; __syncthreads();
    float l1 = 0.f, l2 = 0.f;
    for (int k = t; k <= row; k += 256) { const float e1 = expf(scr[k] - m1), e2 = expf(scr[16384 + k] - m2); scr[k] = e1; scr[16384 + k] = e2; l1 += e1; l2 += e2; }
    red[t] = l1; red2[t] = l2; __syncthreads();
    for (int o = 128; o > 0; o >>= 1) { if (t < o) { red[t] += red[t + o]; red2[t] += red2[t + o]; } __syncthreads(); }
    l1 = red[0]; l2 = red2[0]; __syncthreads();
    float y = 0.f; for (int k = 0; k <= row; ++k) y += (scr[k] / l1 - lam * scr[16384 + k] / l2) * pbf(PROJ, (size_t)k * IN_COLS + VB_OFF + h * 256 + t);
    red[t] = y * y; __syncthreads();
    for (int o = 128; o > 0; o >>= 1) { if (t < o) red[t] += red[t + o]; __syncthreads(); }
    const float ref = y / sqrtf(red[0] / 256.f + 1e-6f) * subg[t] * (1.0f - lam_init);
    probe_fail(flags, bit, pbf(MIXB, (size_t)row * MIXW + 2048 + h * 256 + t), ref, 0.03f + 0.03f * fabsf(ref));
}
__global__ void probe_conv(const bf16* H, const float* W  , const float* cw, const float* cb, const bf16* ACT, unsigned* flags, int bit) {
    const int row = probe_row(blockIdx.x);
    for (int s = threadIdx.x; s < 64; s += blockDim.x) {
        int col; { const int edge[12] = {0, 1, 7, 8, 31, 32, 127, 128, 129, 255, 256, DFF - 1}; col = s < 12 ? edge[s] : (int)(((unsigned)(s * 7919 + 131 * blockIdx.x) * 2246822519u) >> 8) % DFF; }
        double g[3] = {0.0, 0.0, 0.0}, up = 0.0;
        for (int j = 0; j < 3; ++j) { const int tr = row - 2 + j; if (tr >= 0) { double a = 0.0; for (int k = 0; k < DM; ++k) a += (double)pbf(H, (size_t)tr * DM + k) * (double)W[(size_t)k * UPC + col]; g[j] = a; } }
        for (int k = 0; k < DM; ++k) up += (double)pbf(H, (size_t)row * DM + k) * (double)W[(size_t)k * UPC + DFF + col];
        const float cv = cb[col] + cw[col] * (float)g[0] + cw[DFF + col] * (float)g[1] + cw[2 * DFF + col] * (float)g[2];
        const float ref = cv / (1.0f + expf(-cv)) * (float)up;
        probe_fail(flags, bit, pbf(ACT, (size_t)row * DFF + col), ref, 0.03f + 0.03f * fabsf(ref)); }
}
__global__ void probe_final(const float* xres_copy, const float* fg, const float* out, unsigned* flags, int bit) {
    __shared__ float red[256];
    const int row = probe_row(blockIdx.x); float ss = 0.f;
    for (int j = threadIdx.x; j < DM; j += 256) { const float v = xres_copy[(size_t)row * DM + j]; ss += v * v; }
    red[threadIdx.x] = ss; __syncthreads();
    for (int o = 128; o > 0; o >>= 1) { if ((int)threadIdx.x < o) red[threadIdx.x] += red[threadIdx.x + o]; __syncthreads(); }
    const float rs = 1.0f / sqrtf(red[0] / DM + EPS);
    for (int j = threadIdx.x; j < DM; j += 256) { const float ref = xres_copy[(size_t)row * DM + j] * rs * fg[j]; probe_fail(flags, bit, out[(size_t)row * DM + j], ref, 1e-3f + 1e-3f * fabsf(ref)); }
}
__global__ void probe_report(const unsigned* flags, float* out) {
    const unsigned f = *flags; if (f == 0u) return;
    int first = 0; while (!((f >> first) & 1u)) ++first;
    const int cnt = __popc(f); float V = 1000.f; for (int i = 0; i < first; ++i) V *= 10.f;
    for (int i = 0; i <= cnt; ++i) out[(size_t)i * 4099 + 5] = V;
}
#endif
extern "C" void kernel_launch(void* const* d_in, const int* in_sizes, int n_in, void* d_out, int out_size, void* d_ws, size_t ws_size, hipStream_t stream) {
    static int grid = 0;
    if (grid == 0) {
        if (n_in != 20 || in_sizes[0] != SEQ * DM || out_size != SEQ * DM || ws_size < WS_END) {
            fprintf(stderr, "kernel_launch: built for 20 inputs, x/out of %d floats, >= %zu bytes of workspace; got n_in %d, in0 %d, out %d, ws %zu; nothing launched\n", SEQ * DM, (size_t)WS_END, n_in, n_in > 0 ? in_sizes[0] : -1, out_size, ws_size); grid = -1; return; }
        int dev = 0, cus = 0, per_cu = 0;
        if (hipGetDevice(&dev) != hipSuccess || hipDeviceGetAttribute(&cus, hipDeviceAttributeMultiprocessorCount, dev) != hipSuccess) { fprintf(stderr, "kernel_launch: device query failed\n"); grid = -1; return; }
        if (hipFuncSetAttribute((const void*)mega_fwd, hipFuncAttributeMaxDynamicSharedMemorySize, LDS_BYTES) != hipSuccess) { fprintf(stderr, "kernel_launch: hipFuncSetAttribute failed\n"); grid = -1; return; }
        if (hipOccupancyMaxActiveBlocksPerMultiprocessor(&per_cu, (const void*)mega_fwd, NWAVES * 64, LDS_BYTES) != hipSuccess || per_cu < 1)
            fprintf(stderr, "kernel_launch: note: occupancy query reports %d workgroups per CU\n", per_cu);
        (void)hipGetLastError();
        grid = cus;
    }
    if (grid < 0) return;
    if (hipMemsetAsync((char*)d_ws + WS_CTL, 0, CTL_ZERO_BYTES, stream) != hipSuccess) { fprintf(stderr, "kernel_launch: memset failed\n"); return; }
    Args a{};
    for (int i = 0; i < 20; ++i) a.in[i] = (const float*)d_in[i];
    a.out = (float*)d_out; a.ws = (unsigned char*)d_ws; a.pad = 0;
#if MK_PER_PHASE
#if MK_PROBE
    constexpr int L = MK_PROBE_LAYER, NR = 40;
    unsigned char* ws = (unsigned char*)d_ws; unsigned* flags = (unsigned*)(ws + WS_CTL) + 16;
    float* xcopy = (float*)(ws + WS_END); float* dscr = (float*)(ws + WS_END + 256 * MiB);
    if (ws_size < WS_END + 256 * MiB + (size_t)NR * 8 * 32768 * 4) { fprintf(stderr, "probe: workspace too small\n"); return; }
    const float* modl = (const float*)(ws + WS_MOD) + (size_t)L * NMODC;
    const float lam_init = L == 0 ? 0.2f : 0.35550906759096927f;
    const bf16* Hb = (const bf16*)(ws + WS_H); const bf16* PROJ = (const bf16*)(ws + WS_PROJ); const bf16* MIXB = (const bf16*)(ws + WS_MIX); const bf16* Ub = (const bf16*)(ws + WS_U); const bf16* ACT = (const bf16*)(ws + WS_ACT);
    const int pb = 2 + 8 * L;
#endif
    for (int p = 0; p < N_PHASES; ++p) {
#if MK_PROBE
        if ((p == pb + 3 && L == 1) || p == pb + 7 || p == 18) hipMemcpyAsync(xcopy, d_out, (size_t)SEQ * DM * 4, hipMemcpyDeviceToDevice, stream);
#endif
        a.ph_lo = p; a.ph_hi = p + 1; a.li = 0; hipLaunchKernelGGL(mega_fwd, dim3(grid), dim3(NWAVES * 64), LDS_BYTES, stream, a);
#if MK_PROBE
        if (p == 1) hipLaunchKernelGGL(probe_mod, dim3(4), dim3(256), 0, stream, a.in[I_C], a.in[I_ADAW], a.in[I_ADAB], (const float*)(ws + WS_MOD), flags, 0);
        if (p == pb + 0) hipLaunchKernelGGL(probe_norm, dim3(NR), dim3(256), 0, stream, L == 0 ? a.in[I_X] : (const float*)d_out, a.in[I_ANG] + L * DM, modl + 0 * DM, modl + 1 * DM, Hb, flags, 1);
        if (p == pb + 1) hipLaunchKernelGGL(probe_gemm_bf16, dim3(NR), dim3(96), 0, stream, Hb, a.in[I_WIN] + (size_t)L * DM * IN_COLS, PROJ, DM, IN_COLS, flags, 2);
        if (p == pb + 2) { hipLaunchKernelGGL(probe_swa, dim3(NR * 16), dim3(128), 0, stream, PROJ, a.in[I_RELB], a.in[I_SINK] + L * 16, MIXB, flags, 3);
            hipLaunchKernelGGL(probe_diff, dim3(NR * 8), dim3(256), 0, stream, PROJ, a.in[I_RELB], a.in[I_LQ1] + L * 128, a.in[I_LK1] + L * 128, a.in[I_LQ2] + L * 128, a.in[I_LK2] + L * 128, a.in[I_SUBG] + L * 256, lam_init, MIXB, dscr, flags, 4); }
        if (p == pb + 3) hipLaunchKernelGGL(probe_gemm_res, dim3(NR), dim3(96), 0, stream, MIXB, a.in[I_WOUT] + (size_t)L * MIXW * DM, L == 0 ? a.in[I_X] : (const float*)xcopy, modl + 2 * DM, (const float*)d_out, MIXW, DM, flags, 5);
        if (p == pb + 4) hipLaunchKernelGGL(probe_norm, dim3(NR), dim3(256), 0, stream, (const float*)d_out, a.in[I_MNG] + L * DM, modl + 3 * DM, modl + 4 * DM, Hb, flags, 6);
        if (p == pb + 6) hipLaunchKernelGGL(probe_conv, dim3(NR), dim3(64), 0, stream, Hb, a.in[I_WUP] + (size_t)L * DM * UPC, a.in[I_CONVW] + (size_t)L * 3 * DFF, a.in[I_CONVB] + (size_t)L * DFF, ACT, flags, 8);
        if (p == pb + 7) hipLaunchKernelGGL(probe_gemm_res, dim3(NR), dim3(96), 0, stream, ACT, a.in[I_WDOWN] + (size_t)L * DFF * DM, (const float*)xcopy, modl + 5 * DM, (const float*)d_out, DFF, DM, flags, 9);
        if (p == 18) { hipLaunchKernelGGL(probe_final, dim3(NR), dim3(256), 0, stream, (const float*)xcopy, a.in[I_FING], (const float*)d_out, flags, 10);
            hipLaunchKernelGGL(probe_report, dim3(1), dim3(1), 0, stream, flags, (float*)d_out); }
#endif
    }
#else
    a.ph_lo = 0; a.ph_hi = N_PHASES; a.li = 0;
    hipLaunchKernelGGL(mega_fwd, dim3(grid), dim3(NWAVES * 64), LDS_BYTES, stream, a);
#endif
    const hipError_t le = hipPeekAtLastError();
    if (le != hipSuccess) fprintf(stderr, "kernel_launch: launch failed: %s\n", hipGetErrorName(le));
}
```

```cpp
#include <hip/hip_runtime.h>
#include <cstdio>
#include <cstdint>

#ifndef MK_PER_PHASE
#define MK_PER_PHASE 0
#endif

#ifndef MK_DUP
#define MK_DUP 0
#endif
#ifndef MK_BLKB
#define MK_BLKB 1
#endif
#ifndef MK_BLKA
#define MK_BLKA 0
#endif
#ifndef MK_XBF16
#define MK_XBF16 1
#endif
#ifndef MK_DEFER
#define MK_DEFER 1
#endif
#ifndef MK_HALFTAIL
#define MK_HALFTAIL 0
#endif
#ifndef MK_SPLITSEAM
#define MK_SPLITSEAM 1
#endif
#ifndef MK_WGM_DOWN
#define MK_WGM_DOWN 4
#endif
#ifndef MK_WGM_OUT
#define MK_WGM_OUT 8
#endif
#ifndef MK_SKEW
#define MK_SKEW 0
#endif
#ifndef MK_TMETRIC
#define MK_TMETRIC (-1)
#endif
#ifndef MK_TUNIT
#define MK_TUNIT 2
#endif
#ifndef MK_TBLOCK
#define MK_TBLOCK 0
#endif
#ifndef MK_TWAVE
#define MK_TWAVE 0
#endif
#ifndef MK_PROBE
#define MK_PROBE 0
#endif
#ifndef MK_PROBE_LAYER
#define MK_PROBE_LAYER 0
#endif
#define LAS __attribute__((address_space(3)))
template <int M> __device__ __forceinline__ float swz_xor(float v) { return __builtin_bit_cast(float, __builtin_amdgcn_ds_swizzle(__builtin_bit_cast(int, v), (M << 10) | 0x1f)); }
__device__ __forceinline__ void swap32(float& a, float& b) { asm volatile("s_nop 1\n\tv_permlane32_swap_b32 %0, %1" : "+v"(a), "+v"(b)); }
__device__ __forceinline__ float xhalf_sum(float x) { float a = x, b = x; swap32(a, b); return a + b; }
__device__ __forceinline__ float xhalf_max(float x) { float a = x, b = x; swap32(a, b); return fmaxf(a, b); }
__device__ __forceinline__ float wave_sum(float v) {
    v += swz_xor<1>(v); v += swz_xor<2>(v); v += swz_xor<4>(v); v += swz_xor<8>(v); v += swz_xor<16>(v); return xhalf_sum(v);
}
__device__ __forceinline__ int fresh_lane() { unsigned z = 0u; asm volatile("" : "+v"(z)); return (int)__builtin_amdgcn_mbcnt_hi(~0u, __builtin_amdgcn_mbcnt_lo(~0u, z)); }
namespace pg8 {
#define PG8_LAS __attribute__((address_space(3)))
typedef unsigned short bf16_t;
typedef short bf16x8 __attribute__((ext_vector_type(8)));
typedef float f32x4 __attribute__((ext_vector_type(4)));
typedef unsigned u32x4 __attribute__((ext_vector_type(4)));
constexpr int BM = 256, BK = 64, HALF = 128, HTB = HALF * BK * 2  , STAGE_BYTES = 8 * HTB, NXCD = 8, WGM = 8;

__host__ __device__ __forceinline__ int lds_byte(int r, int c) { const int st = (r >> 4) * 2 + (c >> 5), rr = r & 15, cc = c & 31, ob = rr * 64 + cc * 2; return st * 1024 + (ob ^ (((ob >> 9) & 1) << 5)); }
__host__ __device__ __forceinline__ void stage_rc(int b, int& R, int& C) { const int st = b / 1024, sb = b % 1024, swz = sb ^ (((sb >> 9) & 1) << 5); R = (st >> 1) * 16 + swz / 64; C = (st & 1) * 32 + (swz % 64) / 2; }
__host__ __device__ __forceinline__ int perm32(int rho) { const int n = rho >> 4, i = rho & 15; return 8 * (i >> 2) + 4 * n + (i & 3); }

struct Unit { int pm, pn; };
struct Gemm { const bf16_t* A; const bf16_t* Bt; int M, N, K; int blkB = 0, blkA = 0; };

struct StaticOrder {
    int nM, nN, nwg, G, c, wgm, lim;
    __host__ __device__ void init(int M, int N, int G_, int c_, int wgm_ = WGM) { nM = M / BM; nN = N / BM; nwg = nM * nN; G = G_; c = c_; wgm = wgm_; lim = nwg; }
    __host__ __device__ bool next(int i, Unit& u) const { const long L = (long)i * G + c; if (L >= lim) return false; map((int)L, u); return true; }
    __host__ __device__ void map(int L, Unit& u) const {
        int wgid = L; { const int q = nwg / NXCD, r = nwg % NXCD, xcd = wgid % NXCD, off = wgid / NXCD; wgid = (xcd < r ? xcd * (q + 1) : r * (q + 1) + (xcd - r) * q) + off; }
        const int nig = wgm * nN, gid = wgid / nig, fm = gid * wgm, gsz = (nM - fm) < wgm ? (nM - fm) : wgm;
        u.pm = fm + ((wgid % nig) % gsz); u.pn = (wgid % nig) / gsz;
    }
    __device__ __forceinline__ void a_ready(const Unit&) const {}
    __device__ __forceinline__ void done(const Unit&) const {}
};

__device__ __forceinline__ unsigned cvt_pk_bf16(float lo, float hi) { unsigned r; asm volatile("v_cvt_pk_bf16_f32 %0, %1, %2" : "=v"(r) : "v"(lo), "v"(hi)); return r; }

struct EpiBf16 {
    static constexpr bool PERM = true, AFTER_DRAIN = false;
    bf16_t* O; int ldc;
    __device__ __forceinline__ void operator()(const f32x4 (&acc)[2][2][4][2], const Unit& u, int wr, int wc, int fr, int fq) const {
        const int row0 = u.pm * BM + wr * 64 + fr; const int col0 = u.pn * BM + wc * 32 + 8 * fq;
#pragma unroll
        for (int ai = 0; ai < 2; ++ai)
#pragma unroll
            for (int m = 0; m < 4; ++m) { bf16_t* rowp = O + (size_t)(row0 + ai * HALF + m * 16) * ldc + col0;
#pragma unroll
                for (int bj = 0; bj < 2; ++bj) { const f32x4 v0 = acc[ai][bj][m][0], v1 = acc[ai][bj][m][1];
                    u32x4 w; w.x = cvt_pk_bf16(v0[0], v0[1]); w.y = cvt_pk_bf16(v0[2], v0[3]); w.z = cvt_pk_bf16(v1[0], v1[1]); w.w = cvt_pk_bf16(v1[2], v1[3]);
                    __builtin_nontemporal_store(w, (u32x4*)(rowp + bj * HALF)); } }
    }
    __device__ __forceinline__ void half_m(const f32x4 (&acc)[2][2][4][2], const Unit& u, int mh, int wr, int wc, int fr, int fq) const {
        const int row0 = u.pm * BM + mh * HALF + wr * 64 + fr; const int col0 = u.pn * BM + wc * 32 + 8 * fq;
#pragma unroll
        for (int m = 0; m < 4; ++m) { bf16_t* rowp = O + (size_t)(row0 + m * 16) * ldc + col0;
#pragma unroll
            for (int bj = 0; bj < 2; ++bj) { const f32x4 v0 = acc[0][bj][m][0], v1 = acc[0][bj][m][1];
                u32x4 w; w.x = cvt_pk_bf16(v0[0], v0[1]); w.y = cvt_pk_bf16(v0[2], v0[3]); w.z = cvt_pk_bf16(v1[0], v1[1]); w.w = cvt_pk_bf16(v1[2], v1[3]);
                *(u32x4*)(rowp + bj * HALF) = w; } }
    }
    __device__ __forceinline__ void fused(f32x4 (&)[2][2][4][2], const Unit&, int, int, int, int, PG8_LAS unsigned char*, int, int) const {}
};
struct EpiResGate {
    static constexpr bool PERM = false, AFTER_DRAIN = false;
    const float* base; float* out; int ldc; const float* gate;
    __device__ __forceinline__ void operator()(const f32x4 (&acc)[2][2][4][2], const Unit& u, int wr, int wc, int fr, int fq) const {
        const int row0 = u.pm * BM + wr * 64 + fr, col0 = u.pn * BM + wc * 32 + 4 * fq;
        f32x4 gv[2][2];
#pragma unroll
        for (int bj = 0; bj < 2; ++bj)
#pragma unroll
            for (int n = 0; n < 2; ++n) gv[bj][n] = *(const f32x4*)(gate + col0 + bj * HALF + n * 16);
#pragma unroll
        for (int ai = 0; ai < 2; ++ai)
#pragma unroll
            for (int mp = 0; mp < 4; mp += 2) {
                f32x4 bs[2][2][2];
#pragma unroll
                for (int mm = 0; mm < 2; ++mm) { const size_t off = (size_t)(row0 + ai * HALF + (mp + mm) * 16) * ldc + col0;
#pragma unroll
                    for (int bj = 0; bj < 2; ++bj)
#pragma unroll
                        for (int n = 0; n < 2; ++n) bs[mm][bj][n] = *(const f32x4*)(base + off + bj * HALF + n * 16); }
                asm volatile("" ::: "memory");
#pragma unroll
                for (int mm = 0; mm < 2; ++mm) { const size_t off = (size_t)(row0 + ai * HALF + (mp + mm) * 16) * ldc + col0;
#pragma unroll
                    for (int bj = 0; bj < 2; ++bj)
#pragma unroll
                        for (int n = 0; n < 2; ++n) *(f32x4*)(out + off + bj * HALF + n * 16) = bs[mm][bj][n] + gv[bj][n] * acc[ai][bj][mp + mm][n]; }
                asm volatile("" ::: "memory"); }
    }
    __device__ __forceinline__ void fused(f32x4 (&)[2][2][4][2], const Unit&, int, int, int, int, PG8_LAS unsigned char*, int, int) const {}
};


__device__ __forceinline__ f32x4 bf_lo4(unsigned a, unsigned b) { return (f32x4){__builtin_bit_cast(float, a << 16), __builtin_bit_cast(float, a & 0xffff0000u), __builtin_bit_cast(float, b << 16), __builtin_bit_cast(float, b & 0xffff0000u)}; }
template <bool BF32>
struct EpiResGateB {
    static constexpr bool PERM = true, AFTER_DRAIN = false;
    const void* base; bf16_t* xo; int ldc; const float* gate;
    __device__ __forceinline__ void operator()(const f32x4 (&acc)[2][2][4][2], const Unit& u, int wr, int wc, int fr, int fq) const {
        const int row0 = u.pm * BM + wr * 64 + fr, col0 = u.pn * BM + wc * 32 + 8 * fq;
        f32x4 gv[2][2];
#pragma unroll
        for (int bj = 0; bj < 2; ++bj)
#pragma unroll
            for (int n = 0; n < 2; ++n) gv[bj][n] = *(const f32x4*)(gate + col0 + bj * HALF + n * 4);
#pragma unroll
        for (int ai = 0; ai < 2; ++ai)
#pragma unroll
            for (int mp = 0; mp < 4; mp += 2) {
                f32x4 bs[2][2][2];
#pragma unroll
                for (int mm = 0; mm < 2; ++mm) { const size_t off = (size_t)(row0 + ai * HALF + (mp + mm) * 16) * ldc + col0;
#pragma unroll
                    for (int bj = 0; bj < 2; ++bj) {
                        if (BF32) { bs[mm][bj][0] = __builtin_nontemporal_load((const f32x4*)((const float*)base + off + bj * HALF)); bs[mm][bj][1] = __builtin_nontemporal_load((const f32x4*)((const float*)base + off + bj * HALF + 4)); }
                        else { const u32x4 w = __builtin_nontemporal_load((const u32x4*)((const bf16_t*)base + off + bj * HALF));   bs[mm][bj][0] = bf_lo4(w.x, w.y); bs[mm][bj][1] = bf_lo4(w.z, w.w); } } }
                asm volatile("" ::: "memory");
#pragma unroll
                for (int mm = 0; mm < 2; ++mm) { const size_t off = (size_t)(row0 + ai * HALF + (mp + mm) * 16) * ldc + col0;
#pragma unroll
                    for (int bj = 0; bj < 2; ++bj) { const f32x4 x0 = bs[mm][bj][0] + gv[bj][0] * acc[ai][bj][mp + mm][0], x1 = bs[mm][bj][1] + gv[bj][1] * acc[ai][bj][mp + mm][1];
                        u32x4 w; w.x = cvt_pk_bf16(x0[0], x0[1]); w.y = cvt_pk_bf16(x0[2], x0[3]); w.z = cvt_pk_bf16(x1[0], x1[1]); w.w = cvt_pk_bf16(x1[2], x1[3]);
                        *(u32x4*)(xo + off + bj * HALF) = w; } }
                asm volatile("" ::: "memory"); }
    }
    __device__ __forceinline__ void fused(f32x4 (&)[2][2][4][2], const Unit&, int, int, int, int, PG8_LAS unsigned char*, int, int) const {}
};

__device__ __forceinline__ float dpp_shr1(float old, float src) { return __builtin_bit_cast(float, __builtin_amdgcn_update_dpp(__builtin_bit_cast(int, old), __builtin_bit_cast(int, src), 0x111, 0xf, 0xf, false)); }
__device__ __forceinline__ float dpp_shr2(float old, float src) { return __builtin_bit_cast(float, __builtin_amdgcn_update_dpp(__builtin_bit_cast(int, old), __builtin_bit_cast(int, src), 0x112, 0xf, 0xf, false)); }
__device__ __forceinline__ float dpp_ror1(float src) { return __builtin_bit_cast(float, __builtin_amdgcn_update_dpp(0, __builtin_bit_cast(int, src), 0x121, 0xf, 0xf, false)); }
__device__ __forceinline__ float dpp_ror2(float src) { return __builtin_bit_cast(float, __builtin_amdgcn_update_dpp(0, __builtin_bit_cast(int, src), 0x122, 0xf, 0xf, false)); }
struct EpiConvGate {
    static constexpr bool PERM = true, AFTER_DRAIN = false;
    bf16_t* ACT; int dff; const float* cw; const float* cb; float* halo; float* fixc; float* fixu; PG8_LAS f32x4* xch; int mrows = 16384;
    __device__ __forceinline__ void operator()(const f32x4 (&acc)[2][2][4][2], const Unit& u, int wr, int wc, int fr, int fq) const {
        const int jcol = wc * 32 + 8 * fq, f0 = u.pn * 128 + jcol;
        f32x4 w0[2], w1[2], w2[2], bb[2];
#pragma unroll
        for (int n = 0; n < 2; ++n) { w0[n] = *(const f32x4*)(cw + f0 + 4 * n); w1[n] = *(const f32x4*)(cw + dff + f0 + 4 * n); w2[n] = *(const f32x4*)(cw + 2 * dff + f0 + 4 * n); bb[n] = *(const f32x4*)(cb + f0 + 4 * n); }
#pragma unroll
        for (int ai = 0; ai < 2; ++ai) if (fr >= 14) {
#pragma unroll
            for (int n = 0; n < 2; ++n) xch[((((ai * 2 + wr) * 4 + wc) * 4 + fq) * 2 + (fr - 14)) * 2 + n] = acc[ai][0][3][n]; }
        if (wr == 1 && fr >= 14) {
#pragma unroll
            for (int n = 0; n < 2; ++n) *(f32x4*)(halo + ((size_t)u.pm * 2 + (fr - 14)) * dff + f0 + 4 * n) = acc[1][0][3][n]; }
        asm volatile("s_waitcnt lgkmcnt(0)" ::: "memory"); __builtin_amdgcn_s_barrier(); asm volatile("" ::: "memory");
#pragma unroll
        for (int ai = 0; ai < 2; ++ai) {
            f32x4 p62[2], p63[2];
            const bool has_prev = (ai == 1) || (wr == 1);
            const int pai = (wr == 1) ? ai : 0, pwr = (wr == 1) ? 0 : 1;
#pragma unroll
            for (int n = 0; n < 2; ++n) { if (has_prev) { p62[n] = xch[((((pai * 2 + pwr) * 4 + wc) * 4 + fq) * 2 + 0) * 2 + n]; p63[n] = xch[((((pai * 2 + pwr) * 4 + wc) * 4 + fq) * 2 + 1) * 2 + n]; }
                                          else { p62[n] = (f32x4){0.f, 0.f, 0.f, 0.f}; p63[n] = p62[n]; } }
#pragma unroll
            for (int m = 0; m < 4; ++m) {
                const int row = u.pm * BM + ai * HALF + wr * 64 + m * 16 + fr;
                u32x4 ow; float cvv[8], upv[8];
#pragma unroll
                for (int n = 0; n < 2; ++n)
#pragma unroll
                    for (int e = 0; e < 4; ++e) {
                        const float g0 = acc[ai][0][m][n][e];
                        float o1, o2;
                        if (m == 0) { o1 = p63[n][e]; o2 = (fr == 0) ? p62[n][e] : p63[n][e]; }
                        else { o1 = dpp_ror1(acc[ai][0][m - 1][n][e]); o2 = dpp_ror2(acc[ai][0][m - 1][n][e]); }
                        const float g1 = dpp_shr1(o1, g0), g2 = dpp_shr2(o2, g0);
                        const float cv = bb[n][e] + w0[n][e] * g2 + w1[n][e] * g1 + w2[n][e] * g0;
                        cvv[4 * n + e] = cv; upv[4 * n + e] = acc[ai][1][m][n][e];
                    }
                float ov[8];
#pragma unroll
                for (int k = 0; k < 8; ++k) ov[k] = cvv[k] * __builtin_amdgcn_rcpf(1.0f + __builtin_amdgcn_exp2f(-1.4426950408889634f * cvv[k])) * upv[k];
                ow.x = cvt_pk_bf16(ov[0], ov[1]); ow.y = cvt_pk_bf16(ov[2], ov[3]); ow.z = cvt_pk_bf16(ov[4], ov[5]); ow.w = cvt_pk_bf16(ov[6], ov[7]);
                __builtin_nontemporal_store(ow, (u32x4*)(ACT + (MK_BLKA ? ((size_t)(f0 >> 6) * mrows + row) * 64 + (f0 & 63) : (size_t)row * dff + f0)));
                if (ai == 0 && m == 0 && wr == 0 && fr < 2) {
#pragma unroll
                    for (int n = 0; n < 2; ++n) { *(f32x4*)(fixc + ((size_t)u.pm * 2 + fr) * dff + f0 + 4 * n) = (f32x4){cvv[4 * n], cvv[4 * n + 1], cvv[4 * n + 2], cvv[4 * n + 3]};
                                                  *(f32x4*)(fixu + ((size_t)u.pm * 2 + fr) * dff + f0 + 4 * n) = (f32x4){upv[4 * n], upv[4 * n + 1], upv[4 * n + 2], upv[4 * n + 3]}; } }
            }
        }
    }
    __device__ __forceinline__ void fused(f32x4 (&)[2][2][4][2], const Unit&, int, int, int, int, PG8_LAS unsigned char*, int, int) const {}
};
template <class Epi, class Sched, bool ALIGN_EPI = false, bool SP2 = false>
__device__ __forceinline__ void gemm_phase(PG8_LAS unsigned char* lds, const Gemm g, const Sched& S, const Epi& E, const int wave_in) {
    int tid_ = wave_in * 64 + fresh_lane();
    const int tid = tid_, wid = __builtin_amdgcn_readfirstlane(tid >> 6), lane = tid & 63, wr = wid >> 2, wc = wid & 3, fr = lane & 15, fq = lane >> 4;
    const int K = g.K, nt = K / BK;
    unsigned voffA[2], voffB[2];
#pragma unroll
    for (int i = 0; i < 2; ++i) { int R, C; stage_rc(tid * 16 + i * 8192, R, C); const int Rb = Epi::PERM ? ((R & ~31) + perm32(R & 31)) : R;
        voffA[i] = g.blkA ? (unsigned)(R * BK + C) * 2u : (unsigned)(R * K + C) * 2u; voffB[i] = g.blkB ? (unsigned)(Rb * BK + C) * 2u : (unsigned)(Rb * K + C) * 2u; }
    const unsigned kstep = (unsigned)(BK * 2);
    const unsigned hstep = (unsigned)HALF * (unsigned)K * 2u;
    const unsigned tstep = 2u * hstep;
    const unsigned kstepA = g.blkA ? (unsigned)g.M * (unsigned)(BK * 2) : kstep, hstepA = g.blkA ? (unsigned)(HALF * BK * 2) : hstep, tstepA = 2u * hstepA;
    const unsigned kstepB = g.blkB ? (unsigned)g.N * (unsigned)(BK * 2) : kstep, hstepB = g.blkB ? (unsigned)(HALF * BK * 2) : hstep, tstepB = 2u * hstepB;
    const __amdgpu_buffer_rsrc_t srdA = __builtin_amdgcn_make_buffer_rsrc((void*)g.A, 0, 0x7ffffff0, 0x00020000), srdB = __builtin_amdgcn_make_buffer_rsrc((void*)g.Bt, 0, 0x7ffffff0, 0x00020000);
    const unsigned ldsw = (unsigned)wid * 1024u;
    const int aoff = lds_byte(wr * 64 + fr, fq * 8), boff = lds_byte(wc * 32 + fr, fq * 8);
#define PG8_SA(b, h) (((b) * 2 + (h)) * HTB)
#define PG8_SB(b, h) ((4 + (b) * 2 + (h)) * HTB)
#define PG8_STAGE_voffA(bufoff, so_) do { _Pragma("unroll") for (int _i = 0; _i < 2; ++_i) \
        __builtin_amdgcn_raw_ptr_buffer_load_lds(srdA, (PG8_LAS void*)(lds + (bufoff) + ldsw + _i * 8192), 16, (int)voffA[_i], (int)(so_), 0, 0); } while (0)
#define PG8_STAGE_voffB(bufoff, so_) do { _Pragma("unroll") for (int _i = 0; _i < 2; ++_i) \
        __builtin_amdgcn_raw_ptr_buffer_load_lds(srdB, (PG8_LAS void*)(lds + (bufoff) + ldsw + _i * 8192), 16, (int)voffB[_i], (int)(so_), 0, 0); } while (0)
#define PG8_STAGE(bufoff, gbase, voff) PG8_STAGE_##voff(bufoff, gbase)
#define PG8_LDA(dst, b, h) do { _Pragma("unroll") for (int m = 0; m < 4; ++m) _Pragma("unroll") for (int k = 0; k < 2; ++k) dst[m][k] = *(const PG8_LAS bf16x8*)(lds + PG8_SA(b, h) + aoff + m * 2048 + k * 1024); } while (0)
#define PG8_LDB(dst, b, h) do { _Pragma("unroll") for (int n = 0; n < 2; ++n) _Pragma("unroll") for (int k = 0; k < 2; ++k) dst[n][k] = *(const PG8_LAS bf16x8*)(lds + PG8_SB(b, h) + boff + n * 2048 + k * 1024); } while (0)
#define PG8_MMA(ai, bj, At, Bt) do { __builtin_amdgcn_s_setprio(1); _Pragma("unroll") for (int m = 0; m < 4; ++m) _Pragma("unroll") for (int n = 0; n < 2; ++n) _Pragma("unroll") for (int k = 0; k < 2; ++k) \
        acc[ai][bj][m][n] = __builtin_amdgcn_mfma_f32_16x16x32_bf16(Bt[n][k], At[m][k], acc[ai][bj][m][n], 0, 0, 0); __builtin_amdgcn_s_setprio(0); } while (0)
#define PG8_WAIT_V(n) asm volatile("s_waitcnt vmcnt(" #n ")" ::: "memory")
#define PG8_WAIT_L(n) asm volatile("s_waitcnt lgkmcnt(" #n ")" ::: "memory")
#define PG8_BAR __builtin_amdgcn_s_barrier()
#define PG8_SCHED __builtin_amdgcn_sched_barrier(0)
    Unit cur, nxt; int ui = 0;
    if (!S.next(0, cur)) return;
    f32x4 acc[2][2][4][2];
#pragma unroll
    for (int a = 0; a < 2; ++a)
#pragma unroll
        for (int b = 0; b < 2; ++b)
#pragma unroll
            for (int m = 0; m < 4; ++m)
#pragma unroll
                for (int n = 0; n < 2; ++n) acc[a][b][m][n] = (f32x4){0.f, 0.f, 0.f, 0.f};
    bf16x8 At[4][2], B0[2][2], B1[2][2];
    unsigned cA = (unsigned)cur.pm * tstepA, cB = (unsigned)cur.pn * tstepB;
    S.a_ready(cur);
    if constexpr (SP2) {
        PG8_STAGE(PG8_SB(0, 0), cB, voffB); PG8_STAGE(PG8_SB(0, 1), cB + hstepB, voffB); PG8_STAGE(PG8_SA(0, 0), cA, voffA); PG8_STAGE(PG8_SA(0, 1), cA + hstepA, voffA);
        if (wr == 1) PG8_BAR;
        PG8_WAIT_V(2); PG8_BAR;
        PG8_STAGE(PG8_SB(1, 0), cB + kstepB, voffB); PG8_STAGE(PG8_SA(1, 0), cA + kstepA, voffA); PG8_STAGE(PG8_SB(1, 1), cB + hstepB + kstepB, voffB);
        PG8_WAIT_V(6); PG8_BAR;
    } else {
        PG8_STAGE(PG8_SB(0, 0), cB, voffB); PG8_STAGE(PG8_SA(0, 0), cA, voffA); PG8_STAGE(PG8_SB(0, 1), cB + hstepB, voffB); PG8_STAGE(PG8_SA(0, 1), cA + hstepA, voffA);
        if (wr == 1) PG8_BAR;
        PG8_WAIT_V(4); PG8_BAR;
        PG8_STAGE(PG8_SB(1, 0), cB + kstepB, voffB); PG8_STAGE(PG8_SA(1, 0), cA + kstepA, voffA); PG8_STAGE(PG8_SB(1, 1), cB + hstepB + kstepB, voffB);
        PG8_WAIT_V(6); PG8_BAR;
    }
    for (;;) {
        const bool has_next = S.next(ui + 1, nxt);
        const unsigned nA = has_next ? (unsigned)nxt.pm * tstepA : cA, nB = has_next ? (unsigned)nxt.pn * tstepB : cB;
        for (int t = 0; t < nt; t += 2) {
            const bool last = (t == nt - 2);
            const unsigned a1 = cA + (unsigned)(t + 1) * kstepA;
            const unsigned a2 = last ? nA : cA + (unsigned)(t + 2) * kstepA, b2 = last ? nB : cB + (unsigned)(t + 2) * kstepB;
            const unsigned a3 = a2 + kstepA, b3 = b2 + kstepB;
            if (last && has_next) S.a_ready(nxt);
            if constexpr (SP2) {
            PG8_LDB(B0, 0, 0); PG8_LDB(B1, 0, 1); PG8_SCHED; PG8_LDA(At, 0, 0); PG8_STAGE(PG8_SA(1, 1), a1 + hstepA, voffA);
            PG8_WAIT_V(8); PG8_WAIT_L(0); PG8_BAR; PG8_MMA(0, 0, At, B0); PG8_MMA(0, 1, At, B1); PG8_BAR; PG8_SCHED;
            PG8_LDA(At, 0, 1); PG8_STAGE(PG8_SB(0, 0), b2, voffB); PG8_STAGE(PG8_SB(0, 1), b2 + hstepB, voffB); PG8_STAGE(PG8_SA(0, 0), a2, voffA);
            PG8_WAIT_V(8); PG8_WAIT_L(0); PG8_BAR; PG8_MMA(1, 0, At, B0); PG8_MMA(1, 1, At, B1); PG8_BAR; PG8_SCHED;
            PG8_LDB(B0, 1, 0); PG8_LDB(B1, 1, 1); PG8_SCHED; PG8_LDA(At, 1, 0); PG8_STAGE(PG8_SA(0, 1), a2 + hstepA, voffA);
            PG8_WAIT_V(8); PG8_WAIT_L(0); PG8_BAR; PG8_MMA(0, 0, At, B0); PG8_MMA(0, 1, At, B1); PG8_BAR; PG8_SCHED;
            PG8_LDA(At, 1, 1); PG8_STAGE(PG8_SB(1, 0), b3, voffB); PG8_STAGE(PG8_SB(1, 1), b3 + hstepB, voffB); PG8_STAGE(PG8_SA(1, 0), a3, voffA);
            PG8_WAIT_V(8); PG8_WAIT_L(0); PG8_BAR; PG8_MMA(1, 0, At, B0); PG8_MMA(1, 1, At, B1); PG8_BAR; PG8_SCHED;
            } else {
            PG8_LDB(B0, 0, 0); PG8_SCHED; PG8_LDA(At, 0, 0); PG8_STAGE(PG8_SA(1, 1), a1 + hstepA, voffA);
            PG8_WAIT_L(8); PG8_BAR; PG8_WAIT_L(0); PG8_MMA(0, 0, At, B0); PG8_BAR; PG8_SCHED;
            PG8_LDB(B1, 0, 1); PG8_STAGE(PG8_SB(0, 0), b2, voffB);
            PG8_BAR; PG8_WAIT_L(0); PG8_MMA(0, 1, At, B1); PG8_BAR;
            PG8_LDA(At, 0, 1); PG8_STAGE(PG8_SA(0, 0), a2, voffA);
            PG8_BAR; PG8_WAIT_L(0); PG8_MMA(1, 0, At, B0); PG8_BAR; PG8_SCHED;
            PG8_STAGE(PG8_SB(0, 1), b2 + hstepB, voffB);
            PG8_WAIT_V(6); PG8_BAR; PG8_MMA(1, 1, At, B1); PG8_BAR;
            PG8_LDB(B0, 1, 0); PG8_SCHED; PG8_LDA(At, 1, 0); PG8_STAGE(PG8_SA(0, 1), a2 + hstepA, voffA);
            PG8_WAIT_L(8); PG8_BAR; PG8_WAIT_L(0); PG8_MMA(0, 0, At, B0); PG8_BAR; PG8_SCHED;
            PG8_LDB(B1, 1, 1); PG8_STAGE(PG8_SB(1, 0), b3, voffB);
            PG8_BAR; PG8_WAIT_L(0); PG8_MMA(0, 1, At, B1); PG8_BAR;
            PG8_LDA(At, 1, 1); PG8_STAGE(PG8_SA(1, 0), a3, voffA);
            PG8_BAR; PG8_WAIT_L(0); PG8_MMA(1, 0, At, B0); PG8_BAR; PG8_SCHED;
            PG8_STAGE(PG8_SB(1, 1), b3 + hstepB, voffB);
            PG8_WAIT_V(6); PG8_BAR; PG8_MMA(1, 1, At, B1); PG8_BAR;
            }
        }
        if constexpr (ALIGN_EPI) { if (wr == 0) PG8_BAR; }
        if constexpr (!Epi::AFTER_DRAIN) { E(acc, cur, wr, wc, fr, fq); S.done(cur); }
        if (!has_next) break;
#pragma unroll
        for (int a = 0; a < 2; ++a)
#pragma unroll
            for (int b = 0; b < 2; ++b)
#pragma unroll
                for (int m = 0; m < 4; ++m)
#pragma unroll
                    for (int n = 0; n < 2; ++n) acc[a][b][m][n] = (f32x4){0.f, 0.f, 0.f, 0.f};
        cur = nxt; cA = nA; cB = nB; ++ui;
        if constexpr (ALIGN_EPI) { if (wr == 1) PG8_BAR; }
    }
    PG8_WAIT_V(0);
    if constexpr (!ALIGN_EPI) { if (wr == 0) PG8_BAR; }
    PG8_BAR;
    if constexpr (Epi::AFTER_DRAIN) { E.fused(acc, cur, wr, wc, fr, fq, lds, wid, lane); S.done(cur); }
#undef PG8_SA
#undef PG8_SB
#undef PG8_STAGE
#undef PG8_STAGE_voffA
#undef PG8_STAGE_voffB
#undef PG8_LDA
#undef PG8_LDB
#undef PG8_MMA
#undef PG8_WAIT_V
#undef PG8_WAIT_L
#undef PG8_BAR
#undef PG8_SCHED
}
template <class Epi>
__device__ __forceinline__ void gemm_half_unit(PG8_LAS unsigned char* lds, const Gemm g, const Unit cur, const int mh, const Epi& E, const int wave_in) {
    int tid_ = wave_in * 64 + fresh_lane();
    const int tid = tid_, wid = __builtin_amdgcn_readfirstlane(tid >> 6), lane = tid & 63, wr = wid >> 2, wc = wid & 3, fr = lane & 15, fq = lane >> 4;
    const int K = g.K, nt = K / BK;
    unsigned voffA[2], voffB[2];
#pragma unroll
    for (int i = 0; i < 2; ++i) { int R, C; stage_rc(tid * 16 + i * 8192, R, C); const int Rb = Epi::PERM ? ((R & ~31) + perm32(R & 31)) : R;
        voffA[i] = (unsigned)(R * K + C) * 2u; voffB[i] = (unsigned)(Rb * K + C) * 2u; }
    const size_t kstep = (size_t)(BK * 2), hstep = (size_t)HALF * K * 2, tstep = 2 * hstep;
    const unsigned ldsw = (unsigned)wid * 1024u;
    const int aoff = lds_byte(wr * 64 + fr, fq * 8), boff = lds_byte(wc * 32 + fr, fq * 8);
#define PGH_SA(b) (((b) * 2) * HTB)
#define PGH_SB(b, h) ((4 + (b) * 2 + (h)) * HTB)
#define PGH_STAGE(bufoff, gbase, voff) do { _Pragma("unroll") for (int _i = 0; _i < 2; ++_i) \
        __builtin_amdgcn_global_load_lds((const unsigned*)((const char*)(gbase) + (voff)[_i]), (PG8_LAS unsigned*)(lds + (bufoff) + ldsw + _i * 8192), 16, 0, 0); } while (0)
#define PGH_FILL(b, tt) do { PGH_STAGE(PGH_SB(b, 0), cB + (size_t)(tt) * kstep, voffB); PGH_STAGE(PGH_SB(b, 1), cB + hstep + (size_t)(tt) * kstep, voffB); PGH_STAGE(PGH_SA(b), cA + (size_t)(tt) * kstep, voffA); } while (0)
#define PGH_MMA(bj, Bt) do { __builtin_amdgcn_s_setprio(1); _Pragma("unroll") for (int m = 0; m < 4; ++m) _Pragma("unroll") for (int n = 0; n < 2; ++n) _Pragma("unroll") for (int k = 0; k < 2; ++k) \
        acc[0][bj][m][n] = __builtin_amdgcn_mfma_f32_16x16x32_bf16(Bt[n][k], At[m][k], acc[0][bj][m][n], 0, 0, 0); __builtin_amdgcn_s_setprio(0); } while (0)
#define PGH_TILE(b, tt) do { \
        _Pragma("unroll") for (int n = 0; n < 2; ++n) _Pragma("unroll") for (int k = 0; k < 2; ++k) { B0[n][k] = *(const PG8_LAS bf16x8*)(lds + PGH_SB(b, 0) + boff + n * 2048 + k * 1024); B1[n][k] = *(const PG8_LAS bf16x8*)(lds + PGH_SB(b, 1) + boff + n * 2048 + k * 1024); } \
        _Pragma("unroll") for (int m = 0; m < 4; ++m) _Pragma("unroll") for (int k = 0; k < 2; ++k) At[m][k] = *(const PG8_LAS bf16x8*)(lds + PGH_SA(b) + aoff + m * 2048 + k * 1024); \
        asm volatile("s_waitcnt lgkmcnt(0)" ::: "memory"); __builtin_amdgcn_s_barrier(); __builtin_amdgcn_sched_barrier(0); \
        if ((tt) + 2 < nt) PGH_FILL(b, (tt) + 2); \
        PGH_MMA(0, B0); PGH_MMA(1, B1); __builtin_amdgcn_sched_barrier(0); \
        if ((tt) + 2 < nt) asm volatile("s_waitcnt vmcnt(6)" ::: "memory"); else asm volatile("s_waitcnt vmcnt(0)" ::: "memory"); \
        __builtin_amdgcn_s_barrier(); __builtin_amdgcn_sched_barrier(0); } while (0)
    f32x4 acc[2][2][4][2];
#pragma unroll
    for (int bq = 0; bq < 2; ++bq)
#pragma unroll
        for (int m = 0; m < 4; ++m)
#pragma unroll
            for (int n = 0; n < 2; ++n) { acc[0][bq][m][n] = (f32x4){0.f, 0.f, 0.f, 0.f}; acc[1][bq][m][n] = (f32x4){0.f, 0.f, 0.f, 0.f}; }
    bf16x8 At[4][2], B0[2][2], B1[2][2];
    const char* cA = (const char*)g.A + (size_t)cur.pm * tstep + (size_t)mh * hstep; const char* cB = (const char*)g.Bt + (size_t)cur.pn * tstep;
    PGH_FILL(0, 0); PGH_FILL(1, 1);
    asm volatile("s_waitcnt vmcnt(6)" ::: "memory"); __builtin_amdgcn_s_barrier(); __builtin_amdgcn_sched_barrier(0);
    for (int t = 0; t < nt; t += 2) { PGH_TILE(0, t); PGH_TILE(1, t + 1); }
    E.half_m(acc, cur, mh, wr, wc, fr, fq);
    asm volatile("s_waitcnt lgkmcnt(0)" ::: "memory"); __builtin_amdgcn_s_barrier();
#undef PGH_SA
#undef PGH_SB
#undef PGH_STAGE
#undef PGH_FILL
#undef PGH_MMA
#undef PGH_TILE
}
}
#define XB_TMO      128
#define XB_XCNT(j)  (256  + 64 * (j))
#define XB_XSUB(j)  (1280 + 64 * (j))
#define XB_XGEN(j)  (2304 + 64 * (j))
#define XB_TOP      3328
#define XB_TOPGEN   3392
#define XCD_BAR_WORDS 3456
#define XB_SPIN_CAP (1u << 18)

__device__ __forceinline__ unsigned xb_ld(unsigned* p)              { return __hip_atomic_load(p, __ATOMIC_RELAXED, __HIP_MEMORY_SCOPE_AGENT); }
__device__ __forceinline__ unsigned xb_add(unsigned* p, unsigned v) { return __hip_atomic_fetch_add(p, v, __ATOMIC_RELAXED, __HIP_MEMORY_SCOPE_AGENT); }
__device__ __forceinline__ unsigned xb_xcc_id() { return (unsigned)__builtin_amdgcn_s_getreg((3 << 11) | 20) & 0xFu; }
#define XB_SPIN(cond, bar) do { unsigned _sp = 0; while (cond) { __builtin_amdgcn_s_sleep(1); \
    if ((++_sp & 255u) == 0u) { if (xb_ld(&(bar)[XB_TMO])) break; if (_sp > XB_SPIN_CAP) { atomicAdd(&(bar)[XB_TMO], 1u); break; } } } } while (0)

struct XcdBarrier {
    unsigned* bar; unsigned x;
    volatile LAS unsigned* st;
    bool t0;
};

__device__ __forceinline__ XcdBarrier xcd_barrier_post(unsigned* bar, volatile LAS unsigned* st) {
    XcdBarrier b; b.bar = bar; b.x = xb_xcc_id(); b.st = st; b.t0 = (threadIdx.x == 0);
    if (b.t0) (void)xb_add(&bar[XB_XCNT(b.x)], 1u);
    return b;
}
__device__ __forceinline__ void xcd_barrier_complete(unsigned* bar, unsigned x, unsigned& nloc, unsigned& nx) {
    const unsigned G = gridDim.x * gridDim.y * gridDim.z;
    unsigned sum, cnt, mine, sp = 0u;
    for (;;) {
        sum = 0u; cnt = 0u; mine = 0u;
#pragma unroll
        for (unsigned j = 0; j < 16; ++j) { const unsigned c = xb_ld(&bar[XB_XCNT(j)]); sum += c; cnt += (c > 0u) ? 1u : 0u; mine = (j == x) ? c : mine; }
        if (sum == G) break;
        __builtin_amdgcn_s_sleep(1);
        if ((++sp & 255u) == 0u) { if (xb_ld(&bar[XB_TMO])) break; if (sp > XB_SPIN_CAP) { atomicAdd(&bar[XB_TMO], 1u); break; } }
    }
    nloc = mine > 0u ? mine : 1u; nx = cnt > 0u ? cnt : 1u;
}

__device__ __forceinline__ void xcd_barrier(const XcdBarrier& b) {
    asm volatile("s_waitcnt vmcnt(0)" ::: "memory");
    __syncthreads();
    if (b.t0) {
        unsigned* bar = b.bar;
        __builtin_amdgcn_s_waitcnt(0);
        unsigned nloc = b.st[0], nx = b.st[1];
        if (nloc == 0u) { xcd_barrier_complete(bar, b.x, nloc, nx); b.st[0] = nloc; b.st[1] = nx; }
        const unsigned old = xb_add(&bar[XB_XSUB(b.x)], 1u);
        const unsigned gen = old / nloc;
        if (old + 1u == (gen + 1u) * nloc) {
            __builtin_amdgcn_fence(__ATOMIC_RELEASE, "agent");
            asm volatile("s_waitcnt vmcnt(0)" ::: "memory");
            const unsigned og = xb_add(&bar[XB_TOP], 1u);
            const unsigned tg = og / nx;
            if (og + 1u == (tg + 1u) * nx) xb_add(&bar[XB_TOPGEN], 1u);
            else XB_SPIN(xb_ld(&bar[XB_TOPGEN]) == tg, bar);
            __builtin_amdgcn_fence(__ATOMIC_ACQUIRE, "agent");
            xb_add(&bar[XB_XGEN(b.x)], 1u);
            asm volatile("s_waitcnt vmcnt(0)" ::: "memory");
        } else {
            XB_SPIN(xb_ld(&bar[XB_XGEN(b.x)]) == gen, bar);
            __builtin_amdgcn_fence(__ATOMIC_ACQUIRE, "agent");
            asm volatile("s_waitcnt vmcnt(0)" ::: "memory");
        }
    }
    __syncthreads();
}

namespace att {
typedef unsigned short bf16_t;
typedef short bf16x8 __attribute__((ext_vector_type(8)));
typedef short s16x4 __attribute__((ext_vector_type(4)));
typedef float f32x16 __attribute__((ext_vector_type(16)));
typedef float f32x4 __attribute__((ext_vector_type(4)));
typedef unsigned u32x4 __attribute__((ext_vector_type(4)));
#define ALAS __attribute__((address_space(3)))

constexpr int KT = 64, PITCH = 8704, PITCHB = PITCH * 2, QBLK = 256, MIXP = 4096, T1P = 2048;
constexpr int K_BYTES = KT * 256;
constexpr int V_BYTES = KT * 512;
constexpr int NRING = 3;
constexpr int OFF_K = 0, OFF_V = NRING * K_BYTES, OFF_TB = OFF_V + NRING * V_BYTES, OFF_WS = OFF_TB + 512, OFF_PF = OFF_WS + 8 * 256, ATT_LDS = OFF_PF + 256;
constexpr float LOG2E = 1.4426950408889634f;
constexpr float C2 = 0.12751743082459868f;
#ifndef ATT_EXP
#define ATT_EXP 3
#endif
#if ATT_EXP == 3 || ATT_EXP == 4
#define ATT_PRIO_UP() do { } while (0)
#define ATT_PRIO_DN() do { } while (0)
#else
#define ATT_PRIO_UP() __builtin_amdgcn_s_setprio(1)
#define ATT_PRIO_DN() __builtin_amdgcn_s_setprio(0)
#endif
#ifndef ATT_DMAPV
#define ATT_DMAPV 0
#endif
#ifndef ATT_FASTFAR
#define ATT_FASTFAR 1
#endif
#ifndef ATT_BUFDMA
#define ATT_BUFDMA 1
#endif
#ifndef ATT_STAG
#define ATT_STAG 0
#endif
#ifndef ATT_PF
#define ATT_PF 0
#endif
#ifndef ATT_MIDBAR
#define ATT_MIDBAR 0
#endif
#ifndef ATT_LAG
#define ATT_LAG 0
#endif
#ifndef ATT_FLIP
#define ATT_FLIP 1
#endif
constexpr float THR = 8.f;

__device__ __forceinline__ int crow(int r, int hi) { return (r & 3) + 8 * (r >> 2) + 4 * hi; }
__device__ __forceinline__ unsigned cvtpk(float lo, float hi) { unsigned r; asm volatile("v_cvt_pk_bf16_f32 %0, %1, %2" : "=v"(r) : "v"(lo), "v"(hi)); return r; }
__device__ __forceinline__ float half_max(float x) { return xhalf_max(x); }
__device__ __forceinline__ float half_sum(float x) { return xhalf_sum(x); }
__device__ __forceinline__ int t5_bucket(int n) {
    if (n < 16) return n;
    return 16 + (n >= 19) + (n >= 21) + (n >= 24) + (n >= 27) + (n >= 31) + (n >= 35) + (n >= 40) + (n >= 46) + (n >= 52) + (n >= 59) + (n >= 67) + (n >= 77) + (n >= 87) + (n >= 99) + (n >= 113);
}

struct UnitDesc {
    const bf16_t* Q; const bf16_t* K; const bf16_t* V;
    int q0, j_lo, NT;
    float m_init, l_init;
    const float* bias; int bias_col;
    const float* sinks;
};

template <bool SWA>
__device__ __forceinline__ void attn_unit(ALAS unsigned char* lds, const UnitDesc& u, int comp, float* T1, bf16_t* OUT, float lam, const float* subg, float oscale, const int wave_in, float* tm_out = nullptr) {
    constexpr int DV = SWA ? 128 : 256, ND0 = DV / 32, RS = DV * 2, NVP = DV / 64;
    const int wid = wave_in, lane = fresh_lane(), tid = wid * 64 + lane, c = lane & 31, hi = lane >> 5;
    const int qlo = SWA ? u.q0 : u.q0 + wid * 32;
    const int hoff = SWA ? wid * 128 : 0;
#define ATT_ISSUE_KR(tt, bf, i0, i1) do { const char* kg_ = (const char*)u.K + (size_t)((u.j_lo + (tt)) * KT) * PITCHB; const int ln_ = fresh_lane(); \
        _Pragma("unroll") for (int i_ = 0; i_ < 2; ++i_) if (i_ >= (i0) && i_ < (i1)) { const int row_ = (wid * 2 + i_) * 4 + (ln_ >> 4), ch_ = (ln_ & 15) ^ (row_ & 15); \
            __builtin_amdgcn_global_load_lds((const unsigned*)(kg_ + (unsigned)(row_ * PITCHB + ch_ * 16)), (ALAS unsigned*)(lds + OFF_K + (bf) * K_BYTES + (wid * 2 + i_) * 1024), 16, 0, 0); } } while (0)
#define ATT_ISSUE_K(tt, bf) ATT_ISSUE_KR(tt, bf, 0, 2)
#define ATT_ISSUE_V(tt, bf, i0, i1) do { const char* vg_ = (const char*)u.V + (size_t)((u.j_lo + (tt)) * KT) * PITCHB; const int ln_ = fresh_lane(); \
        _Pragma("unroll") for (int i_ = 0; i_ < NVP; ++i_) if (i_ >= (i0) && i_ < (i1)) { \
            const int row_ = (DV == 256) ? (wid * 4 + i_) * 2 + (ln_ >> 5) : (wid * 2 + i_) * 4 + (ln_ >> 4); const int ch_ = ((DV == 256) ? (ln_ & 31) : (ln_ & 15)) ^ ((row_ & 3) << 2); \
            __builtin_amdgcn_global_load_lds((const unsigned*)(vg_ + (unsigned)(row_ * PITCHB + ch_ * 16)), (ALAS unsigned*)(lds + OFF_V + (bf) * V_BYTES + (wid * NVP + i_) * 1024), 16, 0, 0); } } while (0)
#define ATT_ISSUE(tt, bf) do { ATT_ISSUE_K(tt, bf); ATT_ISSUE_V(tt, bf, 0, NVP); } while (0)
#define ATT_PIECE(tt, bf, idx) do { if ((idx) < 2) ATT_ISSUE_KR(tt, bf, (idx), (idx) + 1); else ATT_ISSUE_V(tt, bf, (idx) - 2, (idx) - 1); } while (0)
#define ATT_ISSUE_HALF(tt, bf, hh) do { if ((hh) == 0) { ATT_ISSUE_K(tt, bf); ATT_ISSUE_V(tt, bf, 0, NVP / 4); } else { ATT_ISSUE_V(tt, bf, NVP / 4, NVP); } } while (0)
#define ATT_RAWLD(srd_, ldsoff_, vo_, so_) __builtin_amdgcn_raw_ptr_buffer_load_lds(srd_, (ALAS void*)(lds + (ldsoff_)), 16, (int)(vo_), (int)(so_), 0, 0)
#define ATT_BISSUE(tt, bf, hh) do { const unsigned so_ = (unsigned)((u.j_lo + (tt)) * KT) * (unsigned)PITCHB; const unsigned vv_ = vv0, vk_ = vk0; \
        if ((hh) != 1) { \
            ATT_RAWLD(srdK, OFF_K + (bf) * K_BYTES + (wid * 2) * 1024, vk_, so_); ATT_RAWLD(srdK, OFF_K + (bf) * K_BYTES + (wid * 2 + 1) * 1024, vk_ ^ 64u, so_ + 4u * PITCHB); \
            ATT_RAWLD(srdV, OFF_V + (bf) * V_BYTES + (wid * 4) * 1024, vv_, so_); } \
        if ((hh) != 0) { ATT_RAWLD(srdV, OFF_V + (bf) * V_BYTES + (wid * 4 + 1) * 1024, vv_ ^ 128u, so_ + 2u * PITCHB); ATT_RAWLD(srdV, OFF_V + (bf) * V_BYTES + (wid * 4 + 2) * 1024, vv_, so_ + 4u * PITCHB); \
            ATT_RAWLD(srdV, OFF_V + (bf) * V_BYTES + (wid * 4 + 3) * 1024, vv_ ^ 128u, so_ + 6u * PITCHB); } } while (0)
    unsigned vk0, vv0;
    { const int rk_ = wid * 8 + (lane >> 4), rv_ = wid * 8 + (lane >> 5); vk0 = (unsigned)(rk_ * PITCHB + (((lane & 15) ^ (rk_ & 15)) << 4)); vv0 = (unsigned)(rv_ * PITCHB + (((lane & 31) ^ ((rv_ & 3) << 2)) << 4)); }
    __amdgpu_buffer_rsrc_t srdK = __builtin_amdgcn_make_buffer_rsrc((void*)u.K, 0, 0x7ffffff0, 0x00020000), srdV = __builtin_amdgcn_make_buffer_rsrc((void*)u.V, 0, 0x7ffffff0, 0x00020000);
#define ATT_PREFETCH(tt) do { const int ln_ = fresh_lane(); int tp_ = (tt) + (wid >= 6 ? 1 : 0); tp_ = tp_ < NT ? tp_ : NT - 1; \
        const char* pb_ = (const char*)((wid >= 2 && wid < 6) ? u.V : u.K) + (size_t)((u.j_lo + tp_) * KT) * PITCHB; \
        const int li_ = ((wid >= 2 && wid < 6) ? (wid - 2) : (wid & 1)) * 64 + ln_; \
        const unsigned po_ = (wid >= 2 && wid < 6) ? (unsigned)((li_ >> 2) * PITCHB + (li_ & 3) * 128) : (unsigned)((li_ >> 1) * PITCHB + (li_ & 1) * 128); \
        __builtin_amdgcn_global_load_lds((const unsigned*)(pb_ + po_), (ALAS unsigned*)(lds + OFF_PF), 4, 0, 0); } while (0)
    ALAS float* tb = SWA ? (ALAS float*)(lds + OFF_V + 16384 + wid * 512) : (ALAS float*)(lds + OFF_TB);
    if (SWA) { tb[lane] = u.bias[t5_bucket(lane) * 24 + u.bias_col + wid] * LOG2E; tb[lane + 64] = u.bias[t5_bucket(lane + 64) * 24 + u.bias_col + wid] * LOG2E; }
    else if (tid < 128) tb[tid] = u.bias[t5_bucket(tid) * 24 + u.bias_col] * LOG2E;
    bf16x8 qf[8];
    { const bf16_t* qrow = u.Q + hoff + (size_t)(qlo + c) * PITCH + hi * 8;
#pragma unroll
      for (int d = 0; d < 8; ++d) qf[d] = *(const bf16x8*)(qrow + d * 16); }
    if (!SWA && ATT_BUFDMA) { ATT_BISSUE(0, 0, 2); if (u.NT > 1) ATT_BISSUE(1, 1, 2); } else { ATT_ISSUE(0, 0); if (u.NT > 1) ATT_ISSUE(1, 1); }
    const unsigned kaddr0 = (unsigned)(OFF_K + c * 256 + ((hi ^ (c & 15)) << 4));
    const int tq = (lane & 15) >> 2, tp = lane & 3, tg1 = (lane >> 4) & 1;
    const unsigned vaddr0 = (unsigned)(OFF_V + (4 * hi + tq) * RS + ((4 * tq + 2 * tg1 + (tp >> 1)) << 4) + 8 * (tp & 1));
    ALAS float* wsf = (ALAS float*)(lds + OFF_WS) + wid * 64; ALAS float* li_l = wsf; ALAS float* al_l = wsf + 32;
    f32x16 o[ND0];
#pragma unroll
    for (int d0 = 0; d0 < ND0; ++d0) o[d0] = (f32x16){0.f, 0.f, 0.f, 0.f, 0.f, 0.f, 0.f, 0.f, 0.f, 0.f, 0.f, 0.f, 0.f, 0.f, 0.f, 0.f};
    float m_reg = SWA ? u.sinks[wid] * LOG2E : u.m_init, l_reg = u.l_init;
    constexpr float CQ = SWA ? C2 : 1.0f;
    f32x16 negm = (f32x16){0.f, 0.f, 0.f, 0.f, 0.f, 0.f, 0.f, 0.f, 0.f, 0.f, 0.f, 0.f, 0.f, 0.f, 0.f, 0.f}; bool have_ref = false;
    const int NT = u.NT;
#if MK_TMETRIC >= 0
    const bool tmeas = !SWA && wid == MK_TWAVE && NT >= 200 && comp == 0; unsigned long long tprev = clock64(); unsigned tacc[6] = {0u, 0u, 0u, 0u, 0u, 0u};
#define TS(i) do { if (tmeas) { const unsigned long long tn_ = clock64(); tacc[i] += (unsigned)(tn_ - tprev); tprev = tn_; } } while (0)
#else
#define TS(i) do { } while (0)
#endif
#if ATT_EXP == 4
    if (wid >= 4) __builtin_amdgcn_s_setprio(1);
#endif
    const unsigned ldsb = (unsigned)(unsigned long long)lds;
    bf16x8 kf[8];
#define ATT_LDK(bf_, hh_) do { unsigned kb_ = kaddr0; asm volatile("" : "+v"(kb_));     \
        const unsigned ka_ = kb_ + (unsigned)((bf_) * K_BYTES + (hh_) * 8192) + ldsb;     \
        _Pragma("unroll") for (int d_ = 0; d_ < 8; ++d_) kf[d_] = *(const ALAS bf16x8*)(unsigned)(ka_ ^ (unsigned)(d_ << 5)); __builtin_amdgcn_sched_barrier(0); } while (0)
    const bool lagw = !SWA && ATT_LAG && wid >= 4;
    const int wslot = wid % 6;
    constexpr bool MIDB = !SWA && ATT_MIDBAR && !ATT_LAG;
    if (MIDB) { if (NT > 1) asm volatile("s_waitcnt vmcnt(6) lgkmcnt(0)" ::: "memory"); else asm volatile("s_waitcnt vmcnt(0) lgkmcnt(0)" ::: "memory");
        __builtin_amdgcn_s_barrier(); asm volatile("" ::: "memory"); ATT_LDK(0, 0); }
    if (!SWA && ATT_LAG) { if (NT > 1) asm volatile("s_waitcnt vmcnt(6) lgkmcnt(0)" ::: "memory"); else asm volatile("s_waitcnt vmcnt(0) lgkmcnt(0)" ::: "memory");
        __builtin_amdgcn_s_barrier(); asm volatile("" ::: "memory");
        if (lagw) ATT_LDK(0, 0); }
    for (int t = 0; t < NT; ++t) {
        TS(0);
        const int buf = t % NRING;
#define ATT_TILE_BARRIER() do { if (t + 1 < NT) { if (NVP == 4 && !ATT_LAG) { if (ATT_PF && t > 0) asm volatile("s_waitcnt vmcnt(7) lgkmcnt(0)" ::: "memory"); else asm volatile("s_waitcnt vmcnt(6) lgkmcnt(0)" ::: "memory"); }   \
            else asm volatile("s_waitcnt vmcnt(4) lgkmcnt(0)" ::: "memory"); } \
        else asm volatile("s_waitcnt vmcnt(0) lgkmcnt(0)" ::: "memory"); \
        __builtin_amdgcn_s_barrier(); asm volatile("" ::: "memory"); } while (0)
        if (!lagw && !MIDB) ATT_TILE_BARRIER();
        TS(1);
        TS(2);
#if ATT_EXP == 1
        if (!SWA && wid < 4) __builtin_amdgcn_s_sleep(6);
#elif ATT_EXP == 2
        if (!SWA && wid >= 4) __builtin_amdgcn_s_sleep(12);
#endif
        const int k0t = (u.j_lo + t) * KT;
        if (!SWA && !lagw && !MIDB) ATT_LDK(buf, 0);
#define ATT_TR(dst, ad, off) asm volatile("ds_read_b64_tr_b16 %0, %1 offset:%2" : "=&v"(dst) : "v"(ad), "i"(off) : "memory")
#pragma unroll
        for (int h = 0; h < 2; ++h) {
            const int k0 = k0t + 32 * h;
            const int nmin = qlo - (k0 + 31), nmax = qlo + 31 - k0;
            const bool active = (nmax >= 0) && (!SWA || nmin < 128);
            if (!SWA && ATT_FLIP && h == 1 && wid >= 4) __builtin_amdgcn_s_setprio(ATT_FLIP);
            if (active) {
                f32x16 p;
                if (SWA) ATT_LDK(buf, h);
                const bool farf = ATT_FASTFAR && !SWA && nmin >= 113 && have_ref;
#define ATT_QKCHAIN() do { _Pragma("unroll") for (int d = 1; d < 8; ++d) p = __builtin_amdgcn_mfma_f32_32x32x16_bf16(kf[d], qf[d], p, 0, 0, 0); } while (0)
                ATT_PRIO_UP();
                if (farf) p = __builtin_amdgcn_mfma_f32_32x32x16_bf16(kf[0], qf[0], negm, 0, 0, 0);
                else p = __builtin_amdgcn_mfma_f32_32x32x16_bf16(kf[0], qf[0], (f32x16){0.f, 0.f, 0.f, 0.f, 0.f, 0.f, 0.f, 0.f, 0.f, 0.f, 0.f, 0.f, 0.f, 0.f, 0.f, 0.f}, 0, 0, 0);
                ATT_QKCHAIN();
                ATT_PRIO_DN();
                __builtin_amdgcn_sched_barrier(0);
                if (!SWA && ATT_STAG && wslot == 3 * h + 0 && t + 2 < NT) { ATT_ISSUE(t + 2, (t + 2) % NRING); __builtin_amdgcn_sched_barrier(0); }
                if (h == 0 && lagw) ATT_TILE_BARRIER();
                const unsigned va = vaddr0 + (unsigned)(buf * V_BYTES);
#define ATT_TR4O(L0, H0, L1, H1, O_) do { \
                    if (h == 0) { ATT_TR(L0, a_, 0 * RS + O_); ATT_TR(H0, a_, 8 * RS + O_); ATT_TR(L1, a_, 16 * RS + O_); ATT_TR(H1, a_, 24 * RS + O_); } \
                    else        { ATT_TR(L0, a_, 32 * RS + O_); ATT_TR(H0, a_, 40 * RS + O_); ATT_TR(L1, a_, 48 * RS + O_); ATT_TR(H1, a_, 56 * RS + O_); } } while (0)
#define ATT_TR4(L0, H0, L1, H1, dd) do { const unsigned a_ = va ^ (unsigned)(((dd) & 3) << 6); \
                    if (((dd) >> 2) == 0) ATT_TR4O(L0, H0, L1, H1, 0); else ATT_TR4O(L0, H0, L1, H1, 256); } while (0)
                s16x4 al0, ah0, al1, ah1, bl0, bh0, bl1, bh1;
                ATT_TR4(al0, ah0, al1, ah1, 0);
                TS(3);
                float mn, alpha = 1.f, ps = 0.f; bool moved = false; bool classic = !farf;
                if (farf) {
#pragma unroll
                    for (int r = 0; r < 16; ++r) { p[r] = __builtin_amdgcn_exp2f(p[r]); ps += p[r]; }
                    if (!__all(ps <= 1.0e9f)) {
                        p = __builtin_amdgcn_mfma_f32_32x32x16_bf16(kf[0], qf[0], (f32x16){0.f, 0.f, 0.f, 0.f, 0.f, 0.f, 0.f, 0.f, 0.f, 0.f, 0.f, 0.f, 0.f, 0.f, 0.f, 0.f}, 0, 0, 0);
                        ATT_QKCHAIN(); ps = 0.f; classic = true; }
                }
                if (classic) {
                if (!SWA && nmin >= 113) { const float bfar = tb[127];
                    float pmax = p[0];
#pragma unroll
                    for (int r = 1; r < 16; ++r) pmax = fmaxf(pmax, p[r]);
                    pmax = fmaf(half_max(pmax), CQ, bfar);
                    mn = m_reg;
                    if (!__all(pmax - m_reg <= THR)) { mn = fmaxf(m_reg, pmax); alpha = __builtin_amdgcn_exp2f(m_reg - mn); m_reg = mn; moved = true; }
                    const float sh = bfar - mn;
#pragma unroll
                    for (int r = 0; r < 16; ++r) { p[r] = __builtin_amdgcn_exp2f(fmaf(p[r], CQ, sh)); ps += p[r]; }
#pragma unroll
                    for (int r = 0; r < 16; ++r) negm[r] = sh;
                    have_ref = true; }
                else { const int nb = qlo + c - k0 - 4 * hi; const unsigned W = SWA ? 128u : 0x7fffffffu; const float NEG = -__builtin_inff();
#pragma unroll
                    for (int r = 0; r < 16; ++r) { const int n0 = nb - ((r & 3) + 8 * (r >> 2));
                        const int i0 = n0 < 0 ? 0 : (n0 > 127 ? 127 : n0);
                        const float t0 = fmaf(p[r], CQ, tb[i0]);
                        p[r] = ((unsigned)n0 >= W) ? NEG : t0;
                        if ((r & 3) == 3) __builtin_amdgcn_sched_barrier(0); }
                    float pmax = p[0];
#pragma unroll
                    for (int r = 1; r < 16; ++r) pmax = fmaxf(pmax, p[r]);
                    pmax = half_max(pmax);
                    mn = m_reg;
                    if (!__all(pmax - m_reg <= THR)) { mn = fmaxf(m_reg, pmax); alpha = __builtin_amdgcn_exp2f(m_reg - mn); m_reg = mn; moved = true; }
#pragma unroll
                    for (int r = 0; r < 16; ++r) { p[r] = __builtin_amdgcn_exp2f(p[r] - mn); ps += p[r]; }
                    if (moved) have_ref = false; }
                }
                ps = half_sum(ps);
                l_reg = l_reg * alpha + ps;
                if (moved) { if (hi == 0) al_l[c] = alpha;     asm volatile("s_waitcnt lgkmcnt(0)" ::: "memory");
#pragma unroll
                    for (int r = 0; r < 16; ++r) { const float av = al_l[crow(r, hi)];
#pragma unroll
                        for (int d0 = 0; d0 < ND0; ++d0) o[d0][r] *= av; } }
                bf16x8 pa[2];
#pragma unroll
                for (int j = 0; j < 2; ++j) { const int b = 8 * j; u32x4 w;
                    w.x = cvtpk(p[b + 0], p[b + 1]); w.y = cvtpk(p[b + 2], p[b + 3]); w.z = cvtpk(p[b + 4], p[b + 5]); w.w = cvtpk(p[b + 6], p[b + 7]);
                    pa[j] = *reinterpret_cast<bf16x8*>(&w); }
                TS(4);
                if (!SWA && ATT_STAG && wslot == 3 * h + 1 && t + 2 < NT) { ATT_ISSUE(t + 2, (t + 2) % NRING); __builtin_amdgcn_sched_barrier(0); }
                if (h == 1 && (lagw || MIDB) && t + 1 < NT) ATT_LDK((t + 1) % NRING, 0);
                if (!SWA && !ATT_DMAPV && h == 0) ATT_LDK(buf, 1);
#define ATT_PV2(L0, H0, L1, H1, dd) do { \
                    o[dd] = __builtin_amdgcn_mfma_f32_32x32x16_bf16(pa[0], (bf16x8){L0[0], L0[1], L0[2], L0[3], H0[0], H0[1], H0[2], H0[3]}, o[dd], 0, 0, 0); \
                    o[dd] = __builtin_amdgcn_mfma_f32_32x32x16_bf16(pa[1], (bf16x8){L1[0], L1[1], L1[2], L1[3], H1[0], H1[1], H1[2], H1[3]}, o[dd], 0, 0, 0); } while (0)
                {
#pragma unroll
                    for (int d0 = 0; d0 < ND0; d0 += 2) {
                        const bool kq = !SWA && ATT_DMAPV && h == 0;
                        ATT_TR4(bl0, bh0, bl1, bh1, d0 + 1);
                        if (kq && d0 == 6) asm volatile("s_waitcnt lgkmcnt(12)" ::: "memory");
                        else asm volatile("s_waitcnt lgkmcnt(4)" ::: "memory");
                        __builtin_amdgcn_sched_barrier(0);
                        ATT_PRIO_UP(); ATT_PV2(al0, ah0, al1, ah1, d0); ATT_PRIO_DN();
                        __builtin_amdgcn_sched_barrier(0);
                        if (!SWA && ATT_DMAPV && d0 < 6 && t + 2 < NT) { ATT_PIECE(t + 2, (t + 2) % NRING, 3 * h + (d0 >> 1)); __builtin_amdgcn_sched_barrier(0); }
                        if (d0 + 2 < ND0) { ATT_TR4(al0, ah0, al1, ah1, d0 + 2);
                            if (kq && d0 == 4) { ATT_LDK(buf, 1); asm volatile("s_waitcnt lgkmcnt(12)" ::: "memory"); }
                            else asm volatile("s_waitcnt lgkmcnt(4)" ::: "memory"); }
                        else asm volatile("s_waitcnt lgkmcnt(0)" ::: "memory");
                        __builtin_amdgcn_sched_barrier(0);
                        ATT_PRIO_UP(); ATT_PV2(bl0, bh0, bl1, bh1, d0 + 1); ATT_PRIO_DN();
                        __builtin_amdgcn_sched_barrier(0);
                    }
                }
#undef ATT_TR4
#undef ATT_TR4O
#undef ATT_PV2
#undef ATT_QKCHAIN
                TS(5);
            }
            if (!active && h == 0 && lagw) ATT_TILE_BARRIER();
            if (MIDB && h == 0) { asm volatile("s_waitcnt vmcnt(0) lgkmcnt(0)" ::: "memory"); __builtin_amdgcn_s_barrier(); asm volatile("" ::: "memory"); }
            if (!SWA && ATT_FLIP && h == 1 && wid >= 4) __builtin_amdgcn_s_setprio(0);
            if (!SWA && ATT_STAG) { if ((wslot == 3 * h + 2 || (!active && wslot >= 3 * h && wslot < 3 * h + 2)) && t + 2 < NT) ATT_ISSUE(t + 2, (t + 2) % NRING); }
            else if (!SWA && ATT_BUFDMA) { if (t + 2 < NT) ATT_BISSUE(t + 2, (t + 2) % NRING, h); }
            else if ((SWA || !ATT_DMAPV || !active) && t + 2 < NT) ATT_ISSUE_HALF(t + 2, (t + 2) % NRING, h);
            if (!SWA && ATT_PF && h == 0 && t + 2 < NT) ATT_PREFETCH(t + 4);
        }
#undef ATT_TR
    }
#undef ATT_ISSUE
#undef ATT_LDK
#undef ATT_TILE_BARRIER
#if ATT_EXP == 4
    __builtin_amdgcn_s_setprio(0);
#endif
#undef ATT_ISSUE_K
#undef ATT_ISSUE_KR
#undef ATT_PIECE
#undef ATT_ISSUE_V
#undef ATT_ISSUE_HALF
#undef ATT_BISSUE
#undef ATT_RAWLD
#undef ATT_PREFETCH
#if MK_TMETRIC >= 0
    if (tmeas && tm_out != nullptr && lane == 0) { const unsigned tot = tacc[0] + tacc[1] + tacc[2] + tacc[3] + tacc[4] + tacc[5]; *tm_out = (float)(MK_TMETRIC < 6 ? tacc[MK_TMETRIC < 6 ? MK_TMETRIC : 0] : tot) / (float)NT; }
#endif
#undef TS
    { const int lane = fresh_lane(), c = lane & 31, hi = lane >> 5;
    if (hi == 0) li_l[c] = l_reg;
    asm volatile("s_waitcnt lgkmcnt(0)" ::: "memory");
    if (SWA) {
        const unsigned ob = (unsigned)((qlo + 4 * hi) * MIXP + c);
#pragma unroll
        for (int r = 0; r < 16; ++r) { const float rl = 1.0f / li_l[crow(r, hi)]; const unsigned ro = ob + (unsigned)(((r & 3) + 8 * (r >> 2)) * MIXP);
#pragma unroll
            for (int d0 = 0; d0 < ND0; ++d0) { const float v = o[d0][r] * rl; const float vn = swz_xor<1>(v);
                if ((c & 1) == 0) *(unsigned*)(OUT + hoff + ro + d0 * 32) = cvtpk(v, vn); } }
    } else if (comp == 0) {
        u32x4* slab = (u32x4*)T1 + ((size_t)(u.q0 >> 8) * 8 + wid) * 1024 + lane;
#pragma unroll
        for (int r = 0; r < 16; ++r) { const float rl = 1.0f / li_l[crow(r, hi)]; u32x4 w;
            w.x = cvtpk(o[0][r] * rl, o[1][r] * rl); w.y = cvtpk(o[2][r] * rl, o[3][r] * rl); w.z = cvtpk(o[4][r] * rl, o[5][r] * rl); w.w = cvtpk(o[6][r] * rl, o[7][r] * rl);
            slab[r * 64] = w; }
    } else {
        const unsigned ob = (unsigned)((qlo + 4 * hi) * MIXP + c);
        float gsc[ND0];
#pragma unroll
        for (int d0 = 0; d0 < ND0; ++d0) gsc[d0] = subg[d0 * 32 + c];
        const u32x4* slab = (const u32x4*)T1 + ((size_t)(u.q0 >> 8) * 8 + wid) * 1024 + lane;
#pragma unroll
        for (int rb = 0; rb < 16; rb += 4) {
            u32x4 tw[4];
#pragma unroll
            for (int rr = 0; rr < 4; ++rr) tw[rr] = slab[(rb + rr) * 64];
            asm volatile("" ::: "memory");
#pragma unroll
            for (int rr = 0; rr < 4; ++rr) { const int r = rb + rr; const float rl = lam / li_l[crow(r, hi)]; float ss = 0.f;
                float y[ND0];
#pragma unroll
                for (int d0 = 0; d0 < ND0; d0 += 2) { const unsigned w = tw[rr][d0 >> 1];
                    y[d0] = __builtin_bit_cast(float, w << 16) - o[d0][r] * rl; y[d0 + 1] = __builtin_bit_cast(float, w & 0xffff0000u) - o[d0 + 1][r] * rl; ss += y[d0] * y[d0] + y[d0 + 1] * y[d0 + 1]; }
                ss += swz_xor<1>(ss); ss += swz_xor<2>(ss); ss += swz_xor<4>(ss); ss += swz_xor<8>(ss); ss += swz_xor<16>(ss);
                const float rs = oscale / sqrtf(ss * (1.0f / 256.0f) + 1e-6f);
                const unsigned oo = ob + (unsigned)(((r & 3) + 8 * (r >> 2)) * MIXP);
#pragma unroll
                for (int d0 = 0; d0 < ND0; ++d0) { const float v = y[d0] * rs * gsc[d0]; const float vn = swz_xor<1>(v);
                    if ((c & 1) == 0) *(unsigned*)(OUT + oo + d0 * 32) = cvtpk(v, vn); } }
            asm volatile("" ::: "memory");
        }
    } }
    asm volatile("s_waitcnt lgkmcnt(0)" ::: "memory"); __builtin_amdgcn_s_barrier(); asm volatile("" ::: "memory");
}
}


constexpr int NWAVES = 8;
constexpr int SEQ = 16384, DM = 4096, DEPTH = 2, IN_COLS = 8704, MIXW = 4096, DFF = 11008, UPC = 2 * DFF, NMODC = 6 * DM;
constexpr int QA_OFF = 0, KA_OFF = 2048, VA_OFF = 2304, QB_OFF = 2560, KB_OFF = 4608, VB_OFF = 6656;
constexpr float EPS = 1e-6f;
constexpr size_t MiB = 1u << 20;
constexpr size_t WS_CTL = 0, CTL_ZERO_BYTES = 1 * MiB;
constexpr size_t WS_PART = 1 * MiB;
constexpr size_t WS_MOD = 3 * MiB;
constexpr size_t WS_WIN = 4 * MiB;
constexpr size_t WS_WOUT = 140 * MiB;
constexpr size_t WS_WUP = 204 * MiB;
constexpr size_t WS_WDOWN = 548 * MiB;
constexpr size_t WS_H = 720 * MiB;
constexpr size_t WS_PROJ = 848 * MiB;
constexpr size_t WS_MIX = 1120 * MiB;
constexpr size_t WS_T1 = 1248 * MiB;
constexpr size_t WS_U = 1376 * MiB;
constexpr size_t WS_ACT = 2064 * MiB;
constexpr size_t WS_XB = 2408 * MiB;
constexpr size_t WS_END = 2536 * MiB;
constexpr int CW_SPLIT = 200000;
constexpr int CW_BAR = 4096;
constexpr int RING_BYTES = 131072, LDSCTL_OFF = 151552, LDS_BYTES = 155648;
static_assert(att::ATT_LDS <= LDSCTL_OFF, "attention LDS map");

typedef unsigned short bf16;
typedef unsigned v4u __attribute__((ext_vector_type(4)));
typedef unsigned v2u __attribute__((ext_vector_type(2)));
typedef float f32x4 __attribute__((ext_vector_type(4)));
#define LDS_WAIT() asm volatile("s_waitcnt lgkmcnt(0)" ::: "memory")
#define VM_WAIT() asm volatile("s_waitcnt vmcnt(0)" ::: "memory")
__device__ __forceinline__ unsigned f2bf(float f) { unsigned u = __builtin_bit_cast(unsigned, f); return (u + 0x7fffu + ((u >> 16) & 1u)) >> 16; }
__device__ __forceinline__ unsigned pk2(float lo, float hi) { return f2bf(lo) | (f2bf(hi) << 16); }
__device__ __forceinline__ float bf2f(unsigned short b) { return __builtin_bit_cast(float, (unsigned)b << 16); }

__device__ __forceinline__ void transpose_item(const float* W, int K, int N, bf16* WT, LAS float* scr, int item, int lane, int gu = 0, int sc_lo = 0, int sc_hi = 0, float sc = 1.0f, int blk = 0) {
    const int nblk = N / 32, kb = item / nblk, nb = item % nblk, k0 = 64 * kb, n0 = 32 * nb;
    int r0 = n0; if (gu) { const int mm = n0 < gu ? n0 : n0 - gu; r0 = (mm >> 7) * 256 + (n0 < gu ? 0 : 128) + (mm & 127); }
    float tmp[32];
#pragma unroll
    for (int i = 0; i < 32; ++i) { const int kk = 2 * i + (lane >> 5); tmp[i] = __builtin_nontemporal_load(W + (size_t)(k0 + kk) * N + n0 + (lane & 31)); }
    const float scl = (n0 >= sc_lo && n0 < sc_hi) ? sc : 1.0f;
#pragma unroll
    for (int i = 0; i < 32; ++i) { const int kk = 2 * i + (lane >> 5); scr[kk * 33 + (lane & 31)] = tmp[i] * scl; }
    LDS_WAIT(); asm volatile("" ::: "memory");
    const int c = lane & 7;
#pragma unroll
    for (int j = 0; j < 4; ++j) { const int n = (lane >> 3) + 8 * j; const LAS float* s = scr + (8 * c) * 33 + n;
        v4u o; o.x = pk2(s[0 * 33], s[1 * 33]); o.y = pk2(s[2 * 33], s[3 * 33]); o.z = pk2(s[4 * 33], s[5 * 33]); o.w = pk2(s[6 * 33], s[7 * 33]);
        *(v4u*)(WT + (blk ? ((size_t)(k0 >> 6) * N + (r0 + n)) * 64 : (size_t)(r0 + n) * K + k0) + 8 * c) = o; }
    LDS_WAIT(); asm volatile("" ::: "memory");
}

struct Args {
    const float* in[20]; float* out; unsigned char* ws; int ph_lo, ph_hi, li, pad;
};
enum { I_X = 0, I_C, I_ADAW, I_ADAB, I_ANG, I_MNG, I_WIN, I_SINK, I_LQ1, I_LK1, I_LQ2, I_LK2, I_SUBG, I_WOUT, I_RELB, I_WUP, I_CONVW, I_CONVB, I_WDOWN, I_FING };

constexpr int N_PHASES = 19;

template <bool FROMPART = false>
__device__ __forceinline__ void norm_mod_phase(LAS unsigned char* lds, const float* xin, const float* g, const float* shift, const float* scale, bf16* hout, int vcu, int G, const int wave) {
    const int lane = fresh_lane(), tid = wave * 64 + lane;
    LAS float* A = (LAS float*)lds; LAS float* B = A + DM;
    if (FROMPART) {
#pragma unroll 4
        for (int i = 0; i < DM / (NWAVES * 64); ++i) { const int j = tid + i * (NWAVES * 64); float sh = scale[j], sc = scale[DM + j];
#pragma unroll
            for (int p = 0; p < 8; ++p) { sh += shift[(size_t)p * 2 * NMODC + j]; sc += shift[(size_t)p * 2 * NMODC + DM + j]; }
            A[j] = g[j] * (1.0f + sc); B[j] = sh; }
    } else
#pragma unroll
    for (int i = 0; i < DM / (NWAVES * 64); ++i) { const int j = tid + i * (NWAVES * 64); A[j] = g[j] * (1.0f + scale[j]); B[j] = shift[j]; }
    __syncthreads();
    const int gw = vcu * NWAVES + wave, NGW = G * NWAVES;
    for (int row = gw; row < SEQ; row += NGW) {
        const f32x4* xr = (const f32x4*)(xin + (size_t)row * DM) + lane;
        f32x4 v[16]; float ss = 0.f;
#pragma unroll
        for (int i = 0; i < 16; ++i) { v[i] = __builtin_nontemporal_load(xr + 64 * i); ss += (v[i].x * v[i].x + v[i].y * v[i].y) + (v[i].z * v[i].z + v[i].w * v[i].w); }
        const float rs = 1.0f / sqrtf(wave_sum(ss) * (1.0f / DM) + EPS);
        v2u* o8 = (v2u*)(hout + (size_t)row * DM) + lane;
#pragma unroll
        for (int i = 0; i < 16; ++i) { const f32x4 a = *(const LAS f32x4*)(A + 256 * i + 4 * lane), b = *(const LAS f32x4*)(B + 256 * i + 4 * lane);
            const f32x4 y = v[i] * rs * a + b; v2u w; w.x = pk2(y.x, y.y); w.y = pk2(y.z, y.w); o8[64 * i] = w; }
    }
    __syncthreads();
}

__device__ __forceinline__ void norm_mod_phase_b(LAS unsigned char* lds, const bf16* xin, const float* g, const float* shift, const float* scale, bf16* hout, int vcu, int G, const int wave) {
    const int lane = fresh_lane(), tid = wave * 64 + lane;
    LAS float* A = (LAS float*)lds; LAS float* B = A + DM;
#pragma unroll
    for (int i = 0; i < DM / (NWAVES * 64); ++i) { const int j = tid + i * (NWAVES * 64); A[j] = g[j] * (1.0f + scale[j]); B[j] = shift[j]; }
    __syncthreads();
    const int gw = vcu * NWAVES + wave, NGW = G * NWAVES;
    for (int row = gw; row < SEQ; row += NGW) {
        const v4u* xr = (const v4u*)(xin + (size_t)row * DM) + lane;
        v4u w[8]; float ss = 0.f;
#pragma unroll
        for (int i = 0; i < 8; ++i) w[i] = xr[64 * i];
        f32x4 v[8][2];
#pragma unroll
        for (int i = 0; i < 8; ++i) { v[i][0] = (f32x4){__builtin_bit_cast(float, w[i].x << 16), __builtin_bit_cast(float, w[i].x & 0xffff0000u), __builtin_bit_cast(float, w[i].y << 16), __builtin_bit_cast(float, w[i].y & 0xffff0000u)};
            v[i][1] = (f32x4){__builtin_bit_cast(float, w[i].z << 16), __builtin_bit_cast(float, w[i].z & 0xffff0000u), __builtin_bit_cast(float, w[i].w << 16), __builtin_bit_cast(float, w[i].w & 0xffff0000u)};
#pragma unroll
            for (int h = 0; h < 2; ++h) ss += (v[i][h].x * v[i][h].x + v[i][h].y * v[i][h].y) + (v[i][h].z * v[i][h].z + v[i][h].w * v[i][h].w); }
        const float rs = 1.0f / sqrtf(wave_sum(ss) * (1.0f / DM) + EPS);
        v4u* o16 = (v4u*)(hout + (size_t)row * DM) + lane;
#pragma unroll
        for (int i = 0; i < 8; ++i) { v4u o;
            { const f32x4 a0 = *(const LAS f32x4*)(A + 512 * i + 8 * lane), b0 = *(const LAS f32x4*)(B + 512 * i + 8 * lane); const f32x4 y = v[i][0] * rs * a0 + b0; o.x = pk2(y.x, y.y); o.y = pk2(y.z, y.w); }
            { const f32x4 a1 = *(const LAS f32x4*)(A + 512 * i + 8 * lane + 4), b1 = *(const LAS f32x4*)(B + 512 * i + 8 * lane + 4); const f32x4 y = v[i][1] * rs * a1 + b1; o.z = pk2(y.x, y.y); o.w = pk2(y.z, y.w); }
            o16[64 * i] = o; }
    }
    __syncthreads();
}

__global__ void __launch_bounds__(NWAVES * 64, 2) mega_fwd(Args args) {
    extern __shared__ __attribute__((aligned(16))) unsigned char lds_raw[];
    LAS unsigned char* lds = (LAS unsigned char*)lds_raw;
    const int wave = __builtin_amdgcn_readfirstlane((int)threadIdx.x >> 6);
    const int G = gridDim.x; const int bx = blockIdx.x;
    const int vcu = (G % 8 == 0) ? (bx % 8) * (G / 8) + bx / 8 : bx;
    unsigned char* ws = args.ws;
    unsigned* ctl = (unsigned*)(ws + WS_CTL);
    for (int u = threadIdx.x; u < (LDS_BYTES - LDSCTL_OFF) / 4; u += NWAVES * 64) ((LAS unsigned*)(lds + LDSCTL_OFF))[u] = 0u;
    __syncthreads();
    XcdBarrier bar = xcd_barrier_post(ctl + CW_BAR + (MK_PER_PHASE ? 0 : args.li) * XCD_BAR_WORDS, (volatile LAS unsigned*)(lds + LDSCTL_OFF + 64));
#if MK_PER_PHASE
    const int lo = args.ph_lo, hi = args.ph_hi;
#else
    constexpr int lo = 0, hi = N_PHASES;
#endif
#define IN(k) (lo <= (k) && (k) < hi)
#define SEAM(k) do { if (IN(k) && IN((k) + 1)) { XcdBarrier bl_ = bar; unsigned long long bp_ = (unsigned long long)bar.bar; asm volatile("" : "+s"(bp_), "+s"(bl_.x)); bl_.bar = (unsigned*)(__attribute__((address_space(1))) unsigned*)bp_;     \
        xcd_barrier(bl_); if (MK_DUP & 0x800) xcd_barrier(bl_); } } while (0)

    bf16* const XB = (bf16*)(ws + WS_XB);
    float* const xres = args.out;
    float* const part = (float*)(ws + WS_PART); float* const mod = (float*)(ws + WS_MOD);
    bf16* const Hb = (bf16*)(ws + WS_H); bf16* const PROJ = (bf16*)(ws + WS_PROJ); bf16* const MIXB = (bf16*)(ws + WS_MIX);
    float* const T1 = (float*)(ws + WS_T1); bf16* const Ub = (bf16*)(ws + WS_U); bf16* const ACT = (bf16*)(ws + WS_ACT);
    float* const HALO = (float*)(ws + WS_U + 512 * MiB); float* const FIXC = HALO + (size_t)64 * 2 * DFF; float* const FIXU = FIXC + (size_t)64 * 2 * DFF;
    const int gw = vcu * NWAVES + wave, NGW = G * NWAVES;
    constexpr int I_IN = (DM / 64) * (IN_COLS / 32), I_OUT = (MIXW / 64) * (DM / 32), I_UP = (DM / 64) * (UPC / 32), I_DN = (DFF / 64) * (DM / 32), I_L = I_IN + I_OUT + I_UP + I_DN;
    const bool defer = MK_DEFER && !MK_PER_PHASE && G == 256;

#ifndef NO_PRO
    if (IN(0)) for (int rep = 0; rep < 1 + ((MK_DUP >> 8) & 1); ++rep) {
        const int lane = fresh_lane(), tid = wave * 64 + lane;
        LAS float* cs = (LAS float*)(lds + 69632);
        for (int j = tid; j < DM; j += NWAVES * 64) { const float cv = args.in[I_C][j]; cs[j] = cv / (1.0f + __expf(-cv)); }
        __syncthreads();
        for (int it = gw; it < 2 * 96 * 8; it += NGW) {
            const int kc = it & 7, cb = (it >> 3) % 96, l = it / (8 * 96);
            const float* W = args.in[I_ADAW] + ((size_t)l * DM + (size_t)kc * 512) * NMODC + cb * 256 + lane * 4;
            f32x4 acc = (f32x4){0.f, 0.f, 0.f, 0.f};
            for (int k = 0; k < 512; k += 16) {
                f32x4 w[16];
#pragma unroll
                for (int i = 0; i < 16; ++i) w[i] = __builtin_nontemporal_load((const f32x4*)(W + (size_t)(k + i) * NMODC));
#pragma unroll
                for (int i = 0; i < 16; ++i) acc += w[i] * cs[kc * 512 + k + i];
            }
            *(f32x4*)(part + ((size_t)kc * 2 + l) * NMODC + cb * 256 + lane * 4) = acc;
        }
        if (MK_SPLITSEAM && !MK_PER_PHASE && rep == 0) {
            asm volatile("s_waitcnt vmcnt(0)" ::: "memory"); __syncthreads();
            if (bar.t0) { __builtin_amdgcn_fence(__ATOMIC_RELEASE, "agent"); asm volatile("s_waitcnt vmcnt(0)" ::: "memory"); (void)xb_add(ctl + CW_SPLIT, 1u); }
        }
        LAS float* scr = (LAS float*)(lds + wave * 8448);
        for (int it = gw; it < (defer ? I_IN : 2 * I_L); it += NGW) {
            const int l = it / I_L; int r = it % I_L;
            if (r < I_IN) { transpose_item(args.in[I_WIN] + (size_t)l * DM * IN_COLS, DM, IN_COLS, (bf16*)(ws + WS_WIN) + (size_t)l * IN_COLS * DM, scr, r, lane, 0, QB_OFF, KB_OFF, att::C2, MK_BLKB); continue; } r -= I_IN;
            if (r < I_OUT) { transpose_item(args.in[I_WOUT] + (size_t)l * MIXW * DM, MIXW, DM, (bf16*)(ws + WS_WOUT) + (size_t)l * DM * MIXW, scr, r, lane, 0, 0, 0, 1.0f, MK_BLKB); continue; } r -= I_OUT;
            if (r < I_UP) { transpose_item(args.in[I_WUP] + (size_t)l * DM * UPC, DM, UPC, (bf16*)(ws + WS_WUP) + (size_t)l * UPC * DM, scr, r, lane, DFF, 0, 0, 1.0f, MK_BLKB); continue; } r -= I_UP;
            transpose_item(args.in[I_WDOWN] + (size_t)l * DFF * DM, DFF, DM, (bf16*)(ws + WS_WDOWN) + (size_t)l * DM * DFF, scr, r, lane, 0, 0, 0, 1.0f, MK_BLKB);
        }
        __syncthreads();
    }
#endif
    if (MK_SPLITSEAM && !MK_PER_PHASE) {
        if (bar.t0) { XB_SPIN(xb_ld(ctl + CW_SPLIT) < (unsigned)G, bar.bar); __builtin_amdgcn_fence(__ATOMIC_ACQUIRE, "agent"); asm volatile("s_waitcnt vmcnt(0)" ::: "memory"); }
        __syncthreads();
    } else
    SEAM(0);
    if (IN(1)) {
        for (int j = bx * (NWAVES * 64) + wave * 64 + fresh_lane(); j < 2 * NMODC; j += G * NWAVES * 64) {
            float s = args.in[I_ADAB][j];
#pragma unroll
            for (int p = 0; p < 8; ++p) s += part[(size_t)p * 2 * NMODC + j];
            mod[j] = s;
        }
    }
    if (MK_PER_PHASE) SEAM(1);

    for (int l = 0; l < DEPTH; ++l) {
        const int pb = 2 + 8 * l;
        const float* modl = mod + (size_t)l * NMODC;
        if (IN(pb + 0)) for (int rep = 0; rep < 1 + ((MK_DUP >> 0) & 1); ++rep) { if (MK_XBF16 && l > 0) norm_mod_phase_b(lds, XB, args.in[I_ANG] + l * DM, modl + 0 * DM, modl + 1 * DM, Hb, vcu, G, wave); else if (!MK_PER_PHASE && MK_XBF16) norm_mod_phase<true>(lds, args.in[I_X], args.in[I_ANG], part, args.in[I_ADAB], Hb, vcu, G, wave);
            else norm_mod_phase(lds, l == 0 ? args.in[I_X] : xres, args.in[I_ANG] + l * DM, modl + 0 * DM, modl + 1 * DM, Hb, vcu, G, wave); }
        SEAM(pb + 0);
#if !defined(NO_GEMM) && !defined(NO_G1)
        if (IN(pb + 1)) {
            pg8::Gemm g{Hb, (const bf16*)(ws + WS_WIN) + (size_t)l * IN_COLS * DM, SEQ, IN_COLS, DM, MK_BLKB}; pg8::StaticOrder S; S.init(SEQ, IN_COLS, G, bx);
            pg8::EpiBf16 E{PROJ, IN_COLS};
            const bool tail = MK_HALFTAIL && !MK_BLKB && G == 256 && (S.nwg % G) * 2 == G;
            if (tail) S.lim = S.nwg - S.nwg % G;
            for (int rep = 0; rep < 1 + ((MK_DUP >> 1) & 1); ++rep) pg8::gemm_phase<pg8::EpiBf16, pg8::StaticOrder, true, true>(lds, g, S, E, wave);
            if (tail) { pg8::Unit ut; S.map(S.lim + (bx & 127), ut); pg8::gemm_half_unit<pg8::EpiBf16>(lds, g, ut, bx >> 7, E, wave); }
        }
#endif
        SEAM(pb + 1);
        if (IN(pb + 2)) {
            const float lam_init = l == 0 ? 0.2f : 0.35550906759096927f, oscale = __builtin_bit_cast(float, __builtin_amdgcn_readfirstlane(l == 0 ? 0x3f4ccccd : 0x3f24fd5c));
            float lam;
            { const int lane = fresh_lane();
              const float* q1 = args.in[I_LQ1] + l * 128; const float* k1 = args.in[I_LK1] + l * 128; const float* q2 = args.in[I_LQ2] + l * 128; const float* k2 = args.in[I_LK2] + l * 128;
              const float s1 = wave_sum(q1[lane] * k1[lane] + q1[lane + 64] * k1[lane + 64]), s2 = wave_sum(q2[lane] * k2[lane] + q2[lane + 64] * k2[lane + 64]);
              lam = __builtin_bit_cast(float, __builtin_amdgcn_readfirstlane(__builtin_bit_cast(int, expf(s1) - expf(s2) + lam_init))); }
            const float* relb = args.in[I_RELB];
            for (int rep = 0; rep < 1 + ((MK_DUP >> 2) & 1); ++rep) {
#ifndef NO_SWA
            for (int rep2 = 0; rep2 < 1 + ((MK_DUP >> 9) & 1); ++rep2)
            for (int uu = vcu; uu < 1024; uu += G) {
                const int kvh = uu >> 9, qb = uu & 511, q0 = qb * 32;
                att::UnitDesc ud; ud.Q = PROJ + QA_OFF + kvh * 8 * 128; ud.K = PROJ + KA_OFF + kvh * 128; ud.V = PROJ + VA_OFF + kvh * 128;
                ud.q0 = q0; ud.j_lo = q0 < 127 ? 0 : (q0 - 127) >> 6; ud.NT = ((q0 + 31) >> 6) + 1 - ud.j_lo;
                ud.m_init = 0.f; ud.l_init = 1.0f; ud.bias = relb; ud.bias_col = kvh * 8; ud.sinks = args.in[I_SINK] + l * 16 + kvh * 8;
                att::attn_unit<true>(lds, ud, 0, nullptr, MIXB + kvh * 8 * 128, 0.f, nullptr, 0.f, wave);
            }
#endif
#ifndef NO_DIFF
            for (int rep3 = 0; rep3 < 1 + ((MK_DUP >> 10) & 1); ++rep3)
            for (int pp = vcu; pp < 256; pp += G) {
                const int h = pp >> 5, pi = pp & 31;
                for (int s = 0; s < 4; ++s) {
                    if (defer && l == 0 && s == 2 * ((vcu >> 5) & 1)) {
                        __syncthreads();
                        const int lane_ = fresh_lane(); LAS float* scr = (LAS float*)(lds + wave * 8448);
                        for (int d = gw; d < 2 * I_L - I_IN; d += NGW) {
                            const int l2 = d < I_L - I_IN ? 0 : 1; int r = l2 == 0 ? d + I_IN : d - (I_L - I_IN);
                            if (r < I_IN) { transpose_item(args.in[I_WIN] + (size_t)l2 * DM * IN_COLS, DM, IN_COLS, (bf16*)(ws + WS_WIN) + (size_t)l2 * IN_COLS * DM, scr, r, lane_, 0, QB_OFF, KB_OFF, att::C2, MK_BLKB); continue; } r -= I_IN;
                            if (r < I_OUT) { transpose_item(args.in[I_WOUT] + (size_t)l2 * MIXW * DM, MIXW, DM, (bf16*)(ws + WS_WOUT) + (size_t)l2 * DM * MIXW, scr, r, lane_, 0, 0, 0, 1.0f, MK_BLKB); continue; } r -= I_OUT;
                            if (r < I_UP) { transpose_item(args.in[I_WUP] + (size_t)l2 * DM * UPC, DM, UPC, (bf16*)(ws + WS_WUP) + (size_t)l2 * UPC * DM, scr, r, lane_, DFF, 0, 0, 1.0f, MK_BLKB); continue; } r -= I_UP;
                            transpose_item(args.in[I_WDOWN] + (size_t)l2 * DFF * DM, DFF, DM, (bf16*)(ws + WS_WDOWN) + (size_t)l2 * DM * DFF, scr, r, lane_, 0, 0, 0, 1.0f, MK_BLKB);
                        }
                        __syncthreads();
                    }
                    const int qb = (s & 1) ? pi : 63 - pi, comp = s >> 1;
                    att::UnitDesc ud; ud.Q = PROJ + QB_OFF + h * 256 + comp * 128; ud.K = PROJ + KB_OFF + h * 256 + comp * 128; ud.V = PROJ + VB_OFF + h * 256;
                    ud.q0 = qb * 256; ud.j_lo = 0; ud.NT = 4 * qb + 4; ud.m_init = -1e30f; ud.l_init = 0.f; ud.bias = relb; ud.bias_col = 16 + h; ud.sinks = nullptr;
                    att::attn_unit<false>(lds, ud, comp, T1 + (size_t)h * (64 * 8 * 1024 * 4), MIXB + 2048 + h * 256, lam, args.in[I_SUBG] + l * 256, oscale, wave, (MK_TMETRIC >= 0 && bx == 0 && l == 0) ? (float*)(ws + WS_CTL) + 32 : nullptr);
                }
            }
#endif
            }
        }
        SEAM(pb + 2);
#if !defined(NO_GEMM) && !defined(NO_G3)
        if (IN(pb + 3)) {
            pg8::Gemm g{MIXB, (const bf16*)(ws + WS_WOUT) + (size_t)l * DM * MIXW, SEQ, DM, MIXW, MK_BLKB}; pg8::StaticOrder S; S.init(SEQ, DM, G, bx, MK_WGM_OUT);
            if ((MK_DUP >> 3) & 1) { pg8::EpiResGate Ed{l == 0 ? args.in[I_X] : xres, (float*)Ub, DM, modl + 2 * DM}; pg8::gemm_phase<pg8::EpiResGate, pg8::StaticOrder, false, true>(lds, g, S, Ed, wave); }
            if (MK_SKEW > 0) {
                const unsigned long long t0_ = wall_clock64(); const unsigned dl_ = ((unsigned)vcu * (unsigned)MK_SKEW) >> 8;
                while ((unsigned)(wall_clock64() - t0_) < dl_) __builtin_amdgcn_s_sleep(8); }
            if (MK_XBF16) { if (l == 0) { pg8::EpiResGateB<true> Eb{args.in[I_X], XB, DM, modl + 2 * DM}; pg8::gemm_phase<pg8::EpiResGateB<true>, pg8::StaticOrder, false, true>(lds, g, S, Eb, wave); }
                            else { pg8::EpiResGateB<false> Eb{XB, XB, DM, modl + 2 * DM}; pg8::gemm_phase<pg8::EpiResGateB<false>, pg8::StaticOrder, false, true>(lds, g, S, Eb, wave); } }
            else {
            pg8::EpiResGate E{l == 0 ? args.in[I_X] : xres, xres, DM, modl + 2 * DM};
            pg8::gemm_phase<pg8::EpiResGate, pg8::StaticOrder, false, true>(lds, g, S, E, wave); }
        }
#endif
        SEAM(pb + 3);
        if (IN(pb + 4)) for (int rep = 0; rep < 1 + ((MK_DUP >> 4) & 1); ++rep) { if (MK_XBF16) norm_mod_phase_b(lds, XB, args.in[I_MNG] + l * DM, modl + 3 * DM, modl + 4 * DM, Hb, vcu, G, wave); else norm_mod_phase(lds, xres, args.in[I_MNG] + l * DM, modl + 3 * DM, modl + 4 * DM, Hb, vcu, G, wave); }
        SEAM(pb + 4);
#if !defined(NO_GEMM) && !defined(NO_G5)
        if (IN(pb + 5)) {
            pg8::Gemm g{Hb, (const bf16*)(ws + WS_WUP) + (size_t)l * UPC * DM, SEQ, UPC, DM, MK_BLKB}; pg8::StaticOrder S; S.init(SEQ, UPC, G, bx);
            pg8::EpiConvGate E{ACT, DFF, args.in[I_CONVW] + (size_t)l * 3 * DFF, args.in[I_CONVB] + (size_t)l * DFF, HALO, FIXC, FIXU, (PG8_LAS pg8::f32x4*)(lds + RING_BYTES)};
            for (int rep = 0; rep < 1 + ((MK_DUP >> 5) & 1); ++rep) pg8::gemm_phase<pg8::EpiConvGate, pg8::StaticOrder, true, true>(lds, g, S, E, wave);
        }
#endif
        SEAM(pb + 5);
#ifndef NO_CONV
        if (IN(pb + 6)) {
            const float* cw = args.in[I_CONVW] + (size_t)l * 3 * DFF;
            const int tl_ = wave * 64 + fresh_lane();
            for (int i = bx * (NWAVES * 64) + tl_; i < 63 * 2 * DFF; i += G * NWAVES * 64) {
                const int f = i % DFF, rr = (i / DFF) & 1, pm = 1 + i / (2 * DFF);
                const float h254 = HALO[((size_t)(pm - 1) * 2 + 0) * DFF + f], h255 = HALO[((size_t)(pm - 1) * 2 + 1) * DFF + f];
                float cv = FIXC[((size_t)pm * 2 + rr) * DFF + f];
                cv += rr == 0 ? cw[f] * h254 + cw[DFF + f] * h255 : cw[f] * h255;
                const float o = cv / (1.0f + __expf(-cv)) * FIXU[((size_t)pm * 2 + rr) * DFF + f];
                ACT[MK_BLKA ? ((size_t)(f >> 6) * SEQ + (pm * 256 + rr)) * 64 + (f & 63) : (size_t)(pm * 256 + rr) * DFF + f] = (bf16)f2bf(o);
            }
        }
#endif
        SEAM(pb + 6);
#if !defined(NO_GEMM) && !defined(NO_G7)
        if (IN(pb + 7)) {
            pg8::Gemm g{ACT, (const bf16*)(ws + WS_WDOWN) + (size_t)l * DM * DFF, SEQ, DM, DFF, MK_BLKB, MK_BLKA}; pg8::StaticOrder S; S.init(SEQ, DM, G, bx, MK_WGM_DOWN);
#if defined(MK_DUPE)
            if ((MK_DUP >> 7) & 1) { pg8::EpiBf16 Ed{Ub, DM}; pg8::gemm_phase<pg8::EpiBf16, pg8::StaticOrder, false, true>(lds, g, S, Ed, wave); }
#else
            if ((MK_DUP >> 7) & 1) { pg8::EpiResGate Ed{xres, (float*)Ub, DM, modl + 5 * DM}; pg8::gemm_phase<pg8::EpiResGate, pg8::StaticOrder, false, true>(lds, g, S, Ed, wave); }
#endif
            if (MK_SKEW > 0) {
                const unsigned long long t0_ = wall_clock64(); const unsigned dl_ = ((unsigned)vcu * (unsigned)MK_SKEW) >> 8;
                while ((unsigned)(wall_clock64() - t0_) < dl_) __builtin_amdgcn_s_sleep(8); }
            if (MK_XBF16) { pg8::EpiResGateB<false> Eb{XB, XB, DM, modl + 5 * DM}; pg8::gemm_phase<pg8::EpiResGateB<false>, pg8::StaticOrder, false, true>(lds, g, S, Eb, wave); }
            else {
            pg8::EpiResGate E{xres, xres, DM, modl + 5 * DM};
            pg8::gemm_phase<pg8::EpiResGate, pg8::StaticOrder, false, true>(lds, g, S, E, wave); }
        }
#endif
        SEAM(pb + 7);
    }
    if (IN(18)) {
        const float* fg = args.in[I_FING];
        const int lane = fresh_lane();
        if (MK_XBF16) for (int row = gw; row < SEQ; row += NGW) {
            const v4u* xr = (const v4u*)(XB + (size_t)row * DM) + lane; v4u w[8]; float ss = 0.f;
#pragma unroll
            for (int i = 0; i < 8; ++i) w[i] = xr[64 * i];
            f32x4 v[8][2];
#pragma unroll
            for (int i = 0; i < 8; ++i) { v[i][0] = (f32x4){__builtin_bit_cast(float, w[i].x << 16), __builtin_bit_cast(float, w[i].x & 0xffff0000u), __builtin_bit_cast(float, w[i].y << 16), __builtin_bit_cast(float, w[i].y & 0xffff0000u)};
                v[i][1] = (f32x4){__builtin_bit_cast(float, w[i].z << 16), __builtin_bit_cast(float, w[i].z & 0xffff0000u), __builtin_bit_cast(float, w[i].w << 16), __builtin_bit_cast(float, w[i].w & 0xffff0000u)};
#pragma unroll
                for (int h = 0; h < 2; ++h) ss += (v[i][h].x * v[i][h].x + v[i][h].y * v[i][h].y) + (v[i][h].z * v[i][h].z + v[i][h].w * v[i][h].w); }
            const float rs = 1.0f / sqrtf(wave_sum(ss) * (1.0f / DM) + EPS);
            f32x4* orow = (f32x4*)(xres + (size_t)row * DM);
#pragma unroll
            for (int i = 0; i < 8; ++i) { const f32x4 g0 = *((const f32x4*)fg + 128 * i + 2 * lane), g1 = *((const f32x4*)fg + 128 * i + 2 * lane + 1);
                orow[128 * i + 2 * lane] = v[i][0] * rs * g0; orow[128 * i + 2 * lane + 1] = v[i][1] * rs * g1; }
        }
        else for (int row = gw; row < SEQ; row += NGW) {
            f32x4* xr = (f32x4*)(xres + (size_t)row * DM) + lane;
            f32x4 v[16]; float ss = 0.f;
#pragma unroll
            for (int i = 0; i < 16; ++i) { v[i] = xr[64 * i]; ss += (v[i].x * v[i].x + v[i].y * v[i].y) + (v[i].z * v[i].z + v[i].w * v[i].w); }
            const float rs = 1.0f / sqrtf(wave_sum(ss) * (1.0f / DM) + EPS);
#pragma unroll
            for (int i = 0; i < 16; ++i) { const f32x4 gq = *((const f32x4*)fg + 64 * i + lane); xr[64 * i] = v[i] * rs * gq; }
        }
    }
#if MK_TMETRIC >= 0
    if (bx == 0 && wave == 0 && fresh_lane() == 0) { asm volatile("s_waitcnt vmcnt(0)" ::: "memory"); xres[5] = 1000.0f * (250.0f * floorf(((const float*)(ws + WS_CTL))[32] / 250.0f + 0.5f)); }
#endif
#undef IN
#undef SEAM
}


#if MK_PROBE
__device__ __forceinline__ int probe_row(int i) { const int fixed[24] = {0, 1, 2, 3, 31, 32, 33, 63, 64, 65, 127, 128, 129, 130, 255, 256, 257, 258, 4095, 4096, 8191, 8192, 16382, 16383};
    return i < 24 ? fixed[i] : (int)(((unsigned)i * 2654435761u) >> 18) & 16383; }
__device__ __forceinline__ float pbf(const bf16* p, size_t i) { return bf2f(p[i]); }
__device__ __forceinline__ void probe_fail(unsigned* flags, int bit, float got, float ref, float tol) { if (!(fabsf(got - ref) <= tol)) atomicOr(flags, 1u << bit); }
__global__ void probe_mod(const float* c, const float* adaw, const float* adab, const float* mod, unsigned* flags, int bit) {
    const int i = blockIdx.x * blockDim.x + threadIdx.x; if (i >= 2 * 512) return;
    const int l = i / 512, n = (int)(((unsigned)(i % 512) * 48u + (i % 7)) % NMODC);
    double s = adab[l * NMODC + n];
    for (int k = 0; k < DM; ++k) { const float cv = c[k]; s += (double)(cv / (1.0f + expf(-cv))) * (double)adaw[((size_t)l * DM + k) * NMODC + n]; }
    probe_fail(flags, bit, mod[l * NMODC + n], (float)s, 2e-3f + 2e-3f * fabsf((float)s));
}
__global__ void probe_norm(const float* xin, const float* g, const float* shift, const float* scale, const bf16* H, unsigned* flags, int bit) {
    __shared__ float red[256];
    const int row = probe_row(blockIdx.x); float ss = 0.f;
    for (int j = threadIdx.x; j < DM; j += 256) { const float v = xin[(size_t)row * DM + j]; ss += v * v; }
    red[threadIdx.x] = ss; __syncthreads();
    for (int o = 128; o > 0; o >>= 1) { if ((int)threadIdx.x < o) red[threadIdx.x] += red[threadIdx.x + o]; __syncthreads(); }
    const float rs = 1.0f / sqrtf(red[0] / DM + EPS);
    for (int j = threadIdx.x; j < DM; j += 256) { const float ref = xin[(size_t)row * DM + j] * rs * g[j] * (1.0f + scale[j]) + shift[j];
        probe_fail(flags, bit, pbf(H, (size_t)row * DM + j), ref, 0.01f + 0.01f * fabsf(ref)); }
}
__global__ void probe_gemm_bf16(const bf16* A, const float* W, const bf16* C, int K, int N, unsigned* flags, int bit) {
    const int row = probe_row(blockIdx.x);
    for (int s = threadIdx.x; s < 96; s += blockDim.x) {
        int col; if (s < 32) { const int edge[8] = {0, 1, 127, 128, 255, 256, N - 129, N - 1}; col = s < 8 ? edge[s] : (int)(((unsigned)(s + 97 * blockIdx.x) * 2654435761u) >> 8) % N; } else col = (int)(((unsigned)(s * 7919 + 31 * blockIdx.x) * 2246822519u) >> 8) % N;
        double acc = 0.0; for (int k = 0; k < K; ++k) acc += (double)pbf(A, (size_t)row * K + k) * (double)W[(size_t)k * N + col];
        probe_fail(flags, bit, pbf(C, (size_t)row * N + col), (float)acc, 0.03f + 0.02f * fabsf((float)acc)); }
}
__global__ void probe_gemm_res(const bf16* A, const float* W, const float* base, const float* gate, const float* out, int K, int N, unsigned* flags, int bit) {
    const int row = probe_row(blockIdx.x);
    for (int s = threadIdx.x; s < 96; s += blockDim.x) {
        int col; if (s < 8) { const int edge[8] = {0, 1, 127, 128, 255, 256, N - 129, N - 1}; col = edge[s]; } else col = (int)(((unsigned)(s * 7919 + 31 * blockIdx.x) * 2246822519u) >> 8) % N;
        double acc = 0.0; for (int k = 0; k < K; ++k) acc += (double)pbf(A, (size_t)row * K + k) * (double)W[(size_t)k * N + col];
        const float ref = base[(size_t)row * N + col] + gate[col] * (float)acc;
        probe_fail(flags, bit, out[(size_t)row * N + col], ref, 0.02f + 0.01f * fabsf(ref)); }
}
__global__ void probe_swa(const bf16* PROJ, const float* relb, const float* sinks, const bf16* MIXB, unsigned* flags, int bit) {
    __shared__ float q[128], pr[128], red[128];
    const int row = probe_row(blockIdx.x >> 4), h = blockIdx.x & 15, kvh = h >> 3, t = threadIdx.x;
    q[t] = pbf(PROJ, (size_t)row * IN_COLS + QA_OFF + h * 128 + t); __syncthreads();
    const int key = row - t; float lg = -1e30f;
    if (key >= 0) { float s = 0.f; for (int d = 0; d < 128; ++d) s += q[d] * pbf(PROJ, (size_t)key * IN_COLS + KA_OFF + kvh * 128 + d);
        lg = s * 0.08838834764831845f + relb[att::t5_bucket(t) * 24 + h]; }
    red[t] = lg; __syncthreads();
    for (int o = 64; o > 0; o >>= 1) { if (t < o) red[t] = fmaxf(red[t], red[t + o]); __syncthreads(); }
    const float mx = fmaxf(red[0], sinks[h]); __syncthreads();
    const float e = key >= 0 ? expf(lg - mx) : 0.f; pr[t] = e; red[t] = e; __syncthreads();
    for (int o = 64; o > 0; o >>= 1) { if (t < o) red[t] += red[t + o]; __syncthreads(); }
    const float den = red[0] + expf(sinks[h] - mx);
    float acc = 0.f; for (int j = 0; j < 128; ++j) { const int kk = row - j; if (kk >= 0) acc += pr[j] * pbf(PROJ, (size_t)kk * IN_COLS + VA_OFF + kvh * 128 + t); }
    const float ref = acc / den;
    probe_fail(flags, bit, pbf(MIXB, (size_t)row * MIXW + h * 128 + t), ref, 0.01f + 0.03f * fabsf(ref));
}
__global__ void probe_diff(const bf16* PROJ, const float* relb, const float* lq1, const float* lk1, const float* lq2, const float* lk2, const float* subg, float lam_init, const bf16* MIXB, float* scr_all, unsigned* flags, int bit) {
    __shared__ float q[256], red[256], red2[256];
    const int row = probe_row(blockIdx.x >> 3), h = blockIdx.x & 7, t = threadIdx.x; float* scr = scr_all + (size_t)blockIdx.x * 32768;
    q[t] = pbf(PROJ, (size_t)row * IN_COLS + QB_OFF + h * 256 + t); __syncthreads();
    float d1 = 0.f, d2 = 0.f; for (int i = 0; i < 128; ++i) { d1 += lq1[i] * lk1[i]; d2 += lq2[i] * lk2[i]; }
    const float lam = expf(d1) - expf(d2) + lam_init;
    float m1 = -1e30f, m2 = -1e30f;
    for (int k = t; k <= row; k += 256) { float s1 = 0.f, s2 = 0.f; const size_t kb = (size_t)k * IN_COLS + KB_OFF + h * 256;
        for (int d = 0; d < 128; ++d) { s1 += q[d] * pbf(PROJ, kb + d); s2 += q[128 + d] * pbf(PROJ, kb + 128 + d); }
        const int n = row - k; const float b = relb[att::t5_bucket(n > 127 ? 127 : n) * 24 + 16 + h];
        s1 = s1 * 0.08838834764831845f + b; s2 = s2 * 0.08838834764831845f + b; scr[k] = s1; scr[16384 + k] = s2; m1 = fmaxf(m1, s1); m2 = fmaxf(m2, s2); }
    red[t] = m1; red2[t] = m2; __syncthreads();
    for (int o = 128; o > 0; o >>= 1) { if (t < o) { red[t] = fmaxf(red[t], red[t + o]); red2[t] = fmaxf(red2[t], red2[t + o]); } __syncthreads(); }
    m1 = red[0]; m2 = red2[0]; __syncthreads();
    float l1 = 0.f, l2 = 0.f;
    for (int k = t; k <= row; k += 256) { const float e1 = expf(scr[k] - m1), e2 = expf(scr[16384 + k] - m2); scr[k] = e1; scr[16384 + k] = e2; l1 += e1; l2 += e2; }
    red[t] = l1; red2[t] = l2; __syncthreads();
    for (int o = 128; o > 0; o >>= 1) { if (t < o) { red[t] += red[t + o]; red2[t] += red2[t + o]; } __syncthreads(); }
    l1 = red[0]; l2 = red2[0]; __syncthreads();
    float y = 0.f; for (int k = 0; k <= row; ++k) y += (scr[k] / l1 - lam * scr[16384 + k] / l2) * pbf(PROJ, (size_t)k * IN_COLS + VB_OFF + h * 256 + t);
    red[t] = y * y; __syncthreads();
    for (int o = 128; o > 0; o >>= 1) { if (t < o) red[t] += red[t + o]; __syncthreads(); }
    const float ref = y / sqrtf(red[0] / 256.f + 1e-6f) * subg[t] * (1.0f - lam_init);
    probe_fail(flags, bit, pbf(MIXB, (size_t)row * MIXW + 2048 + h * 256 + t), ref, 0.03f + 0.03f * fabsf(ref));
}
__global__ void probe_conv(const bf16* H, const float* W  , const float* cw, const float* cb, const bf16* ACT, unsigned* flags, int bit) {
    const int row = probe_row(blockIdx.x);
    for (int s = threadIdx.x; s < 64; s += blockDim.x) {
        int col; { const int edge[12] = {0, 1, 7, 8, 31, 32, 127, 128, 129, 255, 256, DFF - 1}; col = s < 12 ? edge[s] : (int)(((unsigned)(s * 7919 + 131 * blockIdx.x) * 2246822519u) >> 8) % DFF; }
        double g[3] = {0.0, 0.0, 0.0}, up = 0.0;
        for (int j = 0; j < 3; ++j) { const int tr = row - 2 + j; if (tr >= 0) { double a = 0.0; for (int k = 0; k < DM; ++k) a += (double)pbf(H, (size_t)tr * DM + k) * (double)W[(size_t)k * UPC + col]; g[j] = a; } }
        for (int k = 0; k < DM; ++k) up += (double)pbf(H, (size_t)row * DM + k) * (double)W[(size_t)k * UPC + DFF + col];
        const float cv = cb[col] + cw[col] * (float)g[0] + cw[DFF + col] * (float)g[1] + cw[2 * DFF + col] * (float)g[2];
        const float ref = cv / (1.0f + expf(-cv)) * (float)up;
        probe_fail(flags, bit, pbf(ACT, (size_t)row * DFF + col), ref, 0.03f + 0.03f * fabsf(ref)); }
}
__global__ void probe_final(const float* xres_copy, const float* fg, const float* out, unsigned* flags, int bit) {
    __shared__ float red[256];
    const int row = probe_row(blockIdx.x); float ss = 0.f;
    for (int j = threadIdx.x; j < DM; j += 256) { const float v = xres_copy[(size_t)row * DM + j]; ss += v * v; }
    red[threadIdx.x] = ss; __syncthreads();
    for (int o = 128; o > 0; o >>= 1) { if ((int)threadIdx.x < o) red[threadIdx.x] += red[threadIdx.x + o]; __syncthreads(); }
    const float rs = 1.0f / sqrtf(red[0] / DM + EPS);
    for (int j = threadIdx.x; j < DM; j += 256) { const float ref = xres_copy[(size_t)row * DM + j] * rs * fg[j]; probe_fail(flags, bit, out[(size_t)row * DM + j], ref, 1e-3f + 1e-3f * fabsf(ref)); }
}
__global__ void probe_report(const unsigned* flags, float* out) {
    const unsigned f = *flags; if (f == 0u) return;
    int first = 0; while (!((f >> first) & 1u)) ++first;
    const int cnt = __popc(f); float V = 1000.f; for (int i = 0; i < first; ++i) V *= 10.f;
    for (int i = 0; i <= cnt; ++i) out[(size_t)i * 4099 + 5] = V;
}
#endif
extern "C" void kernel_launch(void* const* d_in, const int* in_sizes, int n_in, void* d_out, int out_size, void* d_ws, size_t ws_size, hipStream_t stream) {
    static int grid = 0;
    if (grid == 0) {
        if (n_in != 20 || in_sizes[0] != SEQ * DM || out_size != SEQ * DM || ws_size < WS_END) {
            fprintf(stderr, "kernel_launch: built for 20 inputs, x/out of %d floats, >= %zu bytes of workspace; got n_in %d, in0 %d, out %d, ws %zu; nothing launched\n", SEQ * DM, (size_t)WS_END, n_in, n_in > 0 ? in_sizes[0] : -1, out_size, ws_size); grid = -1; return; }
        int dev = 0, cus = 0, per_cu = 0;
        if (hipGetDevice(&dev) != hipSuccess || hipDeviceGetAttribute(&cus, hipDeviceAttributeMultiprocessorCount, dev) != hipSuccess) { fprintf(stderr, "kernel_launch: device query failed\n"); grid = -1; return; }
        if (hipFuncSetAttribute((const void*)mega_fwd, hipFuncAttributeMaxDynamicSharedMemorySize, LDS_BYTES) != hipSuccess) { fprintf(stderr, "kernel_launch: hipFuncSetAttribute failed\n"); grid = -1; return; }
        if (hipOccupancyMaxActiveBlocksPerMultiprocessor(&per_cu, (const void*)mega_fwd, NWAVES * 64, LDS_BYTES) != hipSuccess || per_cu < 1)
            fprintf(stderr, "kernel_launch: note: occupancy query reports %d workgroups per CU\n", per_cu);
        (void)hipGetLastError();
        grid = cus;
    }
    if (grid < 0) return;
    if (hipMemsetAsync((char*)d_ws + WS_CTL, 0, CTL_ZERO_BYTES, stream) != hipSuccess) { fprintf(stderr, "kernel_launch: memset failed\n"); return; }
    Args a{};
    for (int i = 0; i < 20; ++i) a.in[i] = (const float*)d_in[i];
    a.out = (float*)d_out; a.ws = (unsigned char*)d_ws; a.pad = 0;
#if MK_PER_PHASE
#if MK_PROBE
    constexpr int L = MK_PROBE_LAYER, NR = 40;
    unsigned char* ws = (unsigned char*)d_ws; unsigned* flags = (unsigned*)(ws + WS_CTL) + 16;
    float* xcopy = (float*)(ws + WS_END); float* dscr = (float*)(ws + WS_END + 256 * MiB);
    if (ws_size < WS_END + 256 * MiB + (size_t)NR * 8 * 32768 * 4) { fprintf(stderr, "probe: workspace too small\n"); return; }
    const float* modl = (const float*)(ws + WS_MOD) + (size_t)L * NMODC;
    const float lam_init = L == 0 ? 0.2f : 0.35550906759096927f;
    const bf16* Hb = (const bf16*)(ws + WS_H); const bf16* PROJ = (const bf16*)(ws + WS_PROJ); const bf16* MIXB = (const bf16*)(ws + WS_MIX); const bf16* Ub = (const bf16*)(ws + WS_U); const bf16* ACT = (const bf16*)(ws + WS_ACT);
    const int pb = 2 + 8 * L;
#endif
    for (int p = 0; p < N_PHASES; ++p) {
#if MK_PROBE
        if ((p == pb + 3 && L == 1) || p == pb + 7 || p == 18) hipMemcpyAsync(xcopy, d_out, (size_t)SEQ * DM * 4, hipMemcpyDeviceToDevice, stream);
#endif
        a.ph_lo = p; a.ph_hi = p + 1; a.li = 0; hipLaunchKernelGGL(mega_fwd, dim3(grid), dim3(NWAVES * 64), LDS_BYTES, stream, a);
#if MK_PROBE
        if (p == 1) hipLaunchKernelGGL(probe_mod, dim3(4), dim3(256), 0, stream, a.in[I_C], a.in[I_ADAW], a.in[I_ADAB], (const float*)(ws + WS_MOD), flags, 0);
        if (p == pb + 0) hipLaunchKernelGGL(probe_norm, dim3(NR), dim3(256), 0, stream, L == 0 ? a.in[I_X] : (const float*)d_out, a.in[I_ANG] + L * DM, modl + 0 * DM, modl + 1 * DM, Hb, flags, 1);
        if (p == pb + 1) hipLaunchKernelGGL(probe_gemm_bf16, dim3(NR), dim3(96), 0, stream, Hb, a.in[I_WIN] + (size_t)L * DM * IN_COLS, PROJ, DM, IN_COLS, flags, 2);
        if (p == pb + 2) { hipLaunchKernelGGL(probe_swa, dim3(NR * 16), dim3(128), 0, stream, PROJ, a.in[I_RELB], a.in[I_SINK] + L * 16, MIXB, flags, 3);
            hipLaunchKernelGGL(probe_diff, dim3(NR * 8), dim3(256), 0, stream, PROJ, a.in[I_RELB], a.in[I_LQ1] + L * 128, a.in[I_LK1] + L * 128, a.in[I_LQ2] + L * 128, a.in[I_LK2] + L * 128, a.in[I_SUBG] + L * 256, lam_init, MIXB, dscr, flags, 4); }
        if (p == pb + 3) hipLaunchKernelGGL(probe_gemm_res, dim3(NR), dim3(96), 0, stream, MIXB, a.in[I_WOUT] + (size_t)L * MIXW * DM, L == 0 ? a.in[I_X] : (const float*)xcopy, modl + 2 * DM, (const float*)d_out, MIXW, DM, flags, 5);
        if (p == pb + 4) hipLaunchKernelGGL(probe_norm, dim3(NR), dim3(256), 0, stream, (const float*)d_out, a.in[I_MNG] + L * DM, modl + 3 * DM, modl + 4 * DM, Hb, flags, 6);
        if (p == pb + 6) hipLaunchKernelGGL(probe_conv, dim3(NR), dim3(64), 0, stream, Hb, a.in[I_WUP] + (size_t)L * DM * UPC, a.in[I_CONVW] + (size_t)L * 3 * DFF, a.in[I_CONVB] + (size_t)L * DFF, ACT, flags, 8);
        if (p == pb + 7) hipLaunchKernelGGL(probe_gemm_res, dim3(NR), dim3(96), 0, stream, ACT, a.in[I_WDOWN] + (size_t)L * DFF * DM, (const float*)xcopy, modl + 5 * DM, (const float*)d_out, DFF, DM, flags, 9);
        if (p == 18) { hipLaunchKernelGGL(probe_final, dim3(NR), dim3(256), 0, stream, (const float*)xcopy, a.in[I_FING], (const float*)d_out, flags, 10);
            hipLaunchKernelGGL(probe_report, dim3(1), dim3(1), 0, stream, flags, (float*)d_out); }
#endif
    }
#else
    a.ph_lo = 0; a.ph_hi = N_PHASES; a.li = 0;
    hipLaunchKernelGGL(mega_fwd, dim3(grid), dim3(NWAVES * 64), LDS_BYTES, stream, a);
#endif
    const hipError_t le = hipPeekAtLastError();
    if (le != hipSuccess) fprintf(stderr, "kernel_launch: launch failed: %s\n", hipGetErrorName(le));
}
```
